# Optimizing an MI355X kernel written in HIP

```python
import math
import jax
import jax.numpy as jnp
from jax import lax
import numpy as np

D_MODEL = 1024
BATCH = 2
SEQ = 16384
DEPTH = 2

CHUNK = 64
Q_BLOCK = 128
NORM_EPS = 1e-6
ROPE_THETA = 10000.0

DIFF_HEADS = 4
DIFF_QK_DIM = 64
DIFF_V_DIM = 128
MLA_HEADS = 4
MLA_Q_LORA = 384
MLA_KV_LORA = 256
MLA_NOPE = 64
MLA_ROPE = 32
MLA_V_DIM = 128
GDN_HEADS = 4
GDN_K_DIM = 128
GDN_V_DIM = 128
GDN_CONV = 4
FFN_HIDDEN = ((8 * D_MODEL // 3 + 255) // 256) * 256

N_BRANCHES = 3
IN_WIDTHS = (
    DIFF_HEADS * 2 * DIFF_QK_DIM,
    DIFF_HEADS * 2 * DIFF_QK_DIM,
    DIFF_HEADS * DIFF_V_DIM,
    MLA_Q_LORA,
    MLA_KV_LORA + MLA_ROPE,
    GDN_HEADS * GDN_K_DIM,
    GDN_HEADS * GDN_K_DIM,
    GDN_HEADS * GDN_V_DIM,
    GDN_HEADS * GDN_V_DIM,
    GDN_HEADS,
    GDN_HEADS,
    N_BRANCHES * D_MODEL,
)
IN_COLS = sum(IN_WIDTHS)
IN_OFFSETS = tuple(int(o) for o in np.cumsum(IN_WIDTHS)[:-1])

kernel_name = 'hybrid_diff_mla_gdn_streaming_block'


def _rms_norm(x, w):
    xf = x.astype(jnp.float32)
    y = xf * lax.rsqrt(jnp.mean(xf * xf, axis=-1, keepdims=True) + NORM_EPS)
    return (y * w.astype(jnp.float32)).astype(x.dtype)


def _l2_norm(x):
    xf = x.astype(jnp.float32)
    return xf * lax.rsqrt(jnp.sum(xf * xf, axis=-1, keepdims=True) + NORM_EPS)


def _rope(t, pos):
    half = t.shape[-1] // 2
    inv_freq = ROPE_THETA ** (-jnp.arange(half, dtype=jnp.float32) / half)
    ang = pos.astype(jnp.float32)[:, :, None, None] * inv_freq
    cos, sin = jnp.cos(ang), jnp.sin(ang)
    tf = t.astype(jnp.float32)
    t1, t2 = tf[..., :half], tf[..., half:]
    return jnp.concatenate([t1 * cos - t2 * sin, t2 * cos + t1 * sin], axis=-1).astype(t.dtype)


def _causal_dwconv(x, w):
    k_size, seq = w.shape[0], x.shape[1]
    xp = jnp.pad(x, ((0, 0), (k_size - 1, 0), (0, 0)))
    y = xp[:, 0:seq] * w[0]
    for i in range(1, k_size):
        y = y + xp[:, i:i + seq] * w[i]
    return y


def _chunk_causal_softmax(scores, q_start):
    n_keys = scores.shape[-1]
    q_chunk = (q_start + jnp.arange(Q_BLOCK)) // CHUNK
    k_chunk = jnp.arange(n_keys) // CHUNK
    allowed = k_chunk[None, :] <= q_chunk[:, None]
    return jax.nn.softmax(jnp.where(allowed, scores.astype(jnp.float32), -jnp.inf), axis=-1)


def _sweep_query_blocks(body, *qs):
    b, h, s = qs[0].shape[:3]
    nb = s // Q_BLOCK
    blocks = tuple(jnp.moveaxis(q.reshape(b, h, nb, Q_BLOCK, q.shape[-1]), 2, 0) for q in qs)
    out = lax.map(lambda a: body(a[0] * Q_BLOCK, *a[1]), (jnp.arange(nb), blocks))
    return jnp.moveaxis(out, 0, 2).reshape(b, h, s, out.shape[-1])


def _diff_attention(q, k, v, qn_w, kn_w, lam_p, subln_w, lambda_init):
    b, s = v.shape[:2]
    q = _rms_norm(q.reshape(b, s, DIFF_HEADS, 2, DIFF_QK_DIM), qn_w).transpose(0, 2, 3, 1, 4)
    k = _rms_norm(k.reshape(b, s, DIFF_HEADS, 2, DIFF_QK_DIM), kn_w).transpose(0, 2, 3, 1, 4)
    v = v.reshape(b, s, DIFF_HEADS, DIFF_V_DIM).transpose(0, 2, 1, 3)
    lp = lam_p.astype(jnp.float32)
    lam = jnp.exp(jnp.sum(lp[0] * lp[1])) - jnp.exp(jnp.sum(lp[2] * lp[3])) + lambda_init
    k1, k2 = k[:, :, 0], k[:, :, 1]
    scale = DIFF_QK_DIM ** -0.5

    def body(q_start, q1, q2):
        s1 = jnp.einsum('bhqd,bhkd->bhqk', q1, k1, preferred_element_type=jnp.float32) * scale
        s2 = jnp.einsum('bhqd,bhkd->bhqk', q2, k2, preferred_element_type=jnp.float32) * scale
        p = _chunk_causal_softmax(s1, q_start) - lam * _chunk_causal_softmax(s2, q_start)
        return jnp.einsum('bhqk,bhkd->bhqd', p.astype(v.dtype), v)

    o = _sweep_query_blocks(body, q[:, :, 0], q[:, :, 1])
    o = _rms_norm(o, subln_w) * (1.0 - lambda_init)
    return o.transpose(0, 2, 1, 3).reshape(b, s, DIFF_HEADS * DIFF_V_DIM)


def _mla(q_lat, kv_lat, pos, qa_w, q_up, kva_w, kv_up, qn_w, kn_w):
    b, s = q_lat.shape[:2]
    qk_dim = MLA_NOPE + MLA_ROPE
    q = (_rms_norm(q_lat, qa_w) @ q_up).reshape(b, s, MLA_HEADS, qk_dim)
    c_kv, k_rope = kv_lat[..., :MLA_KV_LORA], kv_lat[..., MLA_KV_LORA:]
    kv = (_rms_norm(c_kv, kva_w) @ kv_up).reshape(b, s, MLA_HEADS, MLA_NOPE + MLA_V_DIM)
    k_nope, v = kv[..., :MLA_NOPE], kv[..., MLA_NOPE:]
    k = jnp.concatenate(
        [k_nope, jnp.broadcast_to(k_rope[:, :, None, :], (b, s, MLA_HEADS, MLA_ROPE))], axis=-1)
    q = _rms_norm(q, qn_w)
    k = _rms_norm(k, kn_w)
    q = jnp.concatenate([q[..., :MLA_NOPE], _rope(q[..., MLA_NOPE:], pos)], axis=-1).transpose(0, 2, 1, 3)
    k = jnp.concatenate([k[..., :MLA_NOPE], _rope(k[..., MLA_NOPE:], pos)], axis=-1).transpose(0, 2, 1, 3)
    v = v.transpose(0, 2, 1, 3)
    scale = qk_dim ** -0.5

    def body(q_start, qb):
        sc = jnp.einsum('bhqd,bhkd->bhqk', qb, k, preferred_element_type=jnp.float32) * scale
        p = _chunk_causal_softmax(sc, q_start)
        return jnp.einsum('bhqk,bhkd->bhqd', p.astype(v.dtype), v)

    o = _sweep_query_blocks(body, q)
    return o.transpose(0, 2, 1, 3).reshape(b, s, MLA_HEADS * MLA_V_DIM)


def _chunk_gated_delta_rule(q, k, v, g, beta):
    b, s, h, dk = q.shape
    dv = v.shape[-1]
    n = s // CHUNK

    def chunks(t):
        t = t.reshape(b, n, CHUNK, h, *t.shape[3:])
        return jnp.moveaxis(jnp.swapaxes(t, 2, 3), 1, 0)

    q, k, v, g, beta = (chunks(t) for t in (q, k, v, g, beta))
    g = jnp.cumsum(g, axis=-1)
    idx = jnp.arange(CHUNK)
    incl = idx[:, None] >= idx[None, :]
    strict = idx[:, None] > idx[None, :]
    decay = jnp.exp(jnp.where(incl, g[..., :, None] - g[..., None, :], -jnp.inf))
    k_beta = k * beta[..., None]
    lower = jnp.where(strict, jnp.einsum('nbhid,nbhjd->nbhij', k_beta, k) * decay, 0.0)
    eye = jnp.eye(CHUNK, dtype=jnp.float32)
    t_mat = lax.linalg.triangular_solve(lower + eye, jnp.broadcast_to(eye, lower.shape),
                                        left_side=True, lower=True, unit_diagonal=True)
    u = t_mat @ (v * beta[..., None])
    w = t_mat @ (k_beta * jnp.exp(g)[..., None])
    attn = jnp.where(incl, jnp.einsum('nbhid,nbhjd->nbhij', q, k) * decay, 0.0)

    def step(state, inp):
        q_n, k_n, u_n, w_n, g_n, a_n = inp
        v_new = u_n - jnp.einsum('bhcd,bhde->bhce', w_n, state)
        o = (jnp.einsum('bhcd,bhde->bhce', q_n * jnp.exp(g_n)[..., None], state)
             + jnp.einsum('bhij,bhje->bhie', a_n, v_new))
        g_last = g_n[..., -1]
        state = (state * jnp.exp(g_last)[..., None, None]
                 + jnp.einsum('bhcd,bhce->bhde', k_n * jnp.exp(g_last[..., None] - g_n)[..., None], v_new))
        return state, o

    state0 = jnp.zeros((b, h, dk, dv), jnp.float32)
    _, o = lax.scan(step, state0, (q, k, u, w, g, attn))
    return jnp.swapaxes(jnp.moveaxis(o, 0, 1), 2, 3).reshape(b, s, h, dv)


def _gated_deltanet(q, k, v, z, beta_logit, a, conv_w, a_log, dt_bias, onorm_w):
    b, s = q.shape[:2]
    qk_w = GDN_HEADS * GDN_K_DIM
    qkv = jax.nn.silu(_causal_dwconv(jnp.concatenate([q, k, v], axis=-1), conv_w))
    q, k, v = jnp.split(qkv, [qk_w, 2 * qk_w], axis=-1)
    q = _l2_norm(q.reshape(b, s, GDN_HEADS, GDN_K_DIM)) * GDN_K_DIM ** -0.5
    k = _l2_norm(k.reshape(b, s, GDN_HEADS, GDN_K_DIM))
    v = v.reshape(b, s, GDN_HEADS, GDN_V_DIM).astype(jnp.float32)
    beta = jax.nn.sigmoid(beta_logit.astype(jnp.float32))
    g = -jnp.exp(a_log.astype(jnp.float32)) * jax.nn.softplus(a.astype(jnp.float32) + dt_bias.astype(jnp.float32))
    o = _chunk_gated_delta_rule(q, k, v, g, beta)
    o = _rms_norm(o, onorm_w) * jax.nn.silu(z.reshape(b, s, GDN_HEADS, GDN_V_DIM).astype(jnp.float32))
    return o.reshape(b, s, GDN_HEADS * GDN_V_DIM).astype(z.dtype)


def _swiglu(h, w_gu, w_down):
    gate, up = jnp.split(h @ w_gu, 2, axis=-1)
    return (jax.nn.silu(gate) * up) @ w_down


def setup_inputs(seed: int = 0) -> dict:
    key = jax.random.key(seed)
    keys = list(jax.random.split(key, 40))
    f32 = jnp.float32

    def normal(shape, fan_in, gain=1.0):
        return jax.random.normal(keys.pop(), shape, f32) * (gain * fan_in ** -0.5)

    def gain(d):
        return 1.0 + 0.1 * jax.random.normal(keys.pop(), (DEPTH, d), f32)

    offsets = jax.random.randint(keys.pop(), (BATCH, 1), 0, 64) * CHUNK
    positions = (offsets + jnp.arange(SEQ)[None, :]).astype(jnp.int32)
    dt = jnp.exp(jax.random.uniform(keys.pop(), (DEPTH, GDN_HEADS), f32,
                                    minval=math.log(1e-3), maxval=math.log(1e-1)))
    return {
        'x': jax.random.normal(keys.pop(), (BATCH, SEQ, D_MODEL), f32),
        'c': jax.random.normal(keys.pop(), (BATCH, D_MODEL), f32),
        'positions': positions,
        'ada_w': normal((DEPTH, D_MODEL, 6 * D_MODEL), D_MODEL, 0.5),
        'ada_b': 0.02 * jax.random.normal(keys.pop(), (DEPTH, 6 * D_MODEL), f32),
        'norm1_w': gain(D_MODEL),
        'w_in': normal((DEPTH, D_MODEL, IN_COLS), D_MODEL),
        'diff_qnorm_w': gain(DIFF_QK_DIM),
        'diff_knorm_w': gain(DIFF_QK_DIM),
        'diff_lambda': 0.1 * jax.random.normal(keys.pop(), (DEPTH, 4, DIFF_QK_DIM), f32),
        'diff_subln_w': gain(DIFF_V_DIM),
        'w_o_diff': normal((DEPTH, DIFF_HEADS * DIFF_V_DIM, D_MODEL), DIFF_HEADS * DIFF_V_DIM),
        'mla_qa_norm_w': gain(MLA_Q_LORA),
        'mla_q_up': normal((DEPTH, MLA_Q_LORA, MLA_HEADS * (MLA_NOPE + MLA_ROPE)), MLA_Q_LORA),
        'mla_kva_norm_w': gain(MLA_KV_LORA),
        'mla_kv_up': normal((DEPTH, MLA_KV_LORA, MLA_HEADS * (MLA_NOPE + MLA_V_DIM)), MLA_KV_LORA),
        'mla_qnorm_w': gain(MLA_NOPE + MLA_ROPE),
        'mla_knorm_w': gain(MLA_NOPE + MLA_ROPE),
        'w_o_mla': normal((DEPTH, MLA_HEADS * MLA_V_DIM, D_MODEL), MLA_HEADS * MLA_V_DIM),
        'gdn_conv_w': normal((DEPTH, GDN_CONV, GDN_HEADS * (2 * GDN_K_DIM + GDN_V_DIM)), GDN_CONV),
        'gdn_a_log': jnp.log(jax.random.uniform(keys.pop(), (DEPTH, GDN_HEADS), f32, minval=1.0, maxval=16.0)),
        'gdn_dt_bias': dt + jnp.log(-jnp.expm1(-dt)),
        'gdn_onorm_w': gain(GDN_V_DIM),
        'w_o_gdn': normal((DEPTH, GDN_HEADS * GDN_V_DIM, D_MODEL), GDN_HEADS * GDN_V_DIM),
        'w_out': normal((DEPTH, D_MODEL, D_MODEL), D_MODEL),
        'norm2_w': gain(D_MODEL),
        'ffn_w_gu': normal((DEPTH, D_MODEL, 2 * FFN_HIDDEN), D_MODEL),
        'ffn_w_down': normal((DEPTH, FFN_HIDDEN, D_MODEL), FFN_HIDDEN),
    }


def reference(x, c, positions, ada_w, ada_b, norm1_w, w_in, diff_qnorm_w, diff_knorm_w,
              diff_lambda, diff_subln_w, w_o_diff, mla_qa_norm_w, mla_q_up, mla_kva_norm_w,
              mla_kv_up, mla_qnorm_w, mla_knorm_w, w_o_mla, gdn_conv_w, gdn_a_log, gdn_dt_bias,
              gdn_onorm_w, w_o_gdn, w_out, norm2_w, ffn_w_gu, ffn_w_down):
    for l in range(DEPTH):
        lambda_init = 0.8 - 0.6 * math.exp(-0.3 * l)
        mod = (c @ ada_w[l] + ada_b[l])[:, None, :]
        sh1, sc1, g1, sh2, sc2, g2 = jnp.split(mod, 6, axis=-1)

        h = _rms_norm(x, norm1_w[l]) * (1.0 + sc1) + sh1
        (a_q, a_k, a_v, b_q, b_kv, c_q, c_k, c_v, c_z, c_b, c_a,
         gate_logits) = jnp.split(h @ w_in[l], IN_OFFSETS, axis=-1)
        y_a = _diff_attention(a_q, a_k, a_v, diff_qnorm_w[l], diff_knorm_w[l], diff_lambda[l],
                              diff_subln_w[l], lambda_init) @ w_o_diff[l]
        y_b = _mla(b_q, b_kv, positions, mla_qa_norm_w[l], mla_q_up[l], mla_kva_norm_w[l],
                   mla_kv_up[l], mla_qnorm_w[l], mla_knorm_w[l]) @ w_o_mla[l]
        y_c = _gated_deltanet(c_q, c_k, c_v, c_z, c_b, c_a, gdn_conv_w[l], gdn_a_log[l],
                              gdn_dt_bias[l], gdn_onorm_w[l]) @ w_o_gdn[l]
        gate_a, gate_b, gate_c = jnp.split(jax.nn.sigmoid(gate_logits), N_BRANCHES, axis=-1)
        merged = gate_a * y_a + gate_b * y_b + gate_c * y_c
        x = x + g1 * (merged @ w_out[l])

        h = _rms_norm(x, norm2_w[l]) * (1.0 + sc2) + sh2
        x = x + g2 * _swiglu(h, ffn_w_gu[l], ffn_w_down[l])
    return x
```

```cpp
#include <hip/hip_runtime.h>
#include <hip/hip_cooperative_groups.h>
#include <cstdio>
#include <cstdint>
namespace cg = cooperative_groups;

#ifndef ONE_LAUNCH
#define ONE_LAUNCH 1
#endif

typedef unsigned short bf16_t;
typedef short bf16x8 __attribute__((ext_vector_type(8)));
typedef float f32x4 __attribute__((ext_vector_type(4)));
typedef float f32x16 __attribute__((ext_vector_type(16)));
typedef unsigned u32x4 __attribute__((ext_vector_type(4)));
typedef unsigned u32x2 __attribute__((ext_vector_type(2)));
#define DI __device__ __forceinline__

constexpr int TT = 16384;
constexpr int NIN = 7424;
constexpr int FH = 2816;
constexpr float EPS = 1e-6f;
constexpr float LOG2E = 1.4426950408889634f;

struct Params {
  const float *x, *c; const int* pos;
  const float *ada_w, *ada_b, *norm1_w, *w_in, *dqn, *dkn, *dlam, *dsub, *wod, *qa_nw, *q_up, *kva_nw, *kv_up,
      *mqn, *mkn, *wom, *convw, *alog, *dtb, *onw, *wog, *wout, *norm2_w, *wgu, *wdown;
  float* out; unsigned char* ws;
};

constexpr size_t MiB = 1ull << 20;
constexpr size_t OFF_CTR = 0, OFF_MOD = 65536, OFF_W = 1 * MiB;
constexpr size_t W_IN = 0;
constexpr size_t W_OA = W_IN + (size_t)NIN * 1024 * 2;
constexpr size_t W_OB = W_OA + 1024 * 512 * 2;
constexpr size_t W_OC = W_OB + 1024 * 512 * 2;
constexpr size_t W_QUP = W_OC + 1024 * 512 * 2;
constexpr size_t W_KVUP = W_QUP + 384 * 384 * 2;
constexpr size_t W_OUT = W_KVUP + 768 * 256 * 2;
constexpr size_t W_GU = W_OUT + 1024 * 1024 * 2;
constexpr size_t W_DOWN = W_GU + (size_t)5632 * 1024 * 2;
constexpr size_t W_LAYER = W_DOWN + (size_t)1024 * 2816 * 2;
static_assert(OFF_W + 2 * W_LAYER <= 76 * MiB, "weights");
constexpr size_t OFF_HB = 76 * MiB;
constexpr size_t OFF_RA = 108 * MiB;
constexpr size_t OFF_RB = 156 * MiB;
constexpr size_t OFF_RC = 180 * MiB;
constexpr size_t OFF_RZ = 228 * MiB;
constexpr size_t OFF_RG = 244 * MiB;
constexpr size_t OFF_BA = 340 * MiB;
constexpr size_t OFF_YQ = 341 * MiB;
constexpr size_t OFF_CQ = 353 * MiB;
constexpr size_t OFF_VTA = 401 * MiB;
constexpr size_t OFF_QB = 417 * MiB;
constexpr size_t OFF_KB = 429 * MiB;
constexpr size_t OFF_VTB = 441 * MiB;
constexpr size_t OFF_UT = 457 * MiB;
constexpr size_t OFF_ATT = 473 * MiB;
constexpr size_t OFF_GC = 481 * MiB;
constexpr size_t OFF_O1 = 482 * MiB;
constexpr size_t WS_NEED = 498 * MiB;

DI int otid() { int t = (int)__builtin_amdgcn_workitem_id_x(); asm volatile("" : "+v"(t)); return t; }
DI float bf2f(unsigned h) { return __uint_as_float(h << 16); }
typedef __bf16 bf16x2_t __attribute__((ext_vector_type(2)));
typedef float f32x2_t __attribute__((ext_vector_type(2)));
DI unsigned pk2(float lo, float hi) { f32x2_t v; v[0] = lo; v[1] = hi; bf16x2_t b = __builtin_convertvector(v, bf16x2_t); return __builtin_bit_cast(unsigned, b); }
DI bf16_t f2bf(float f) { return (bf16_t)(pk2(f, 0.f) & 0xffffu); }
DI float bflo(unsigned u) { return __uint_as_float(u << 16); }
DI float bfhi(unsigned u) { return __uint_as_float(u & 0xffff0000u); }
DI f32x4 mfma16(bf16x8 a, bf16x8 b, f32x4 c) { return __builtin_amdgcn_mfma_f32_16x16x32_bf16(a, b, c, 0, 0, 0); }
DI f32x16 mfma32(bf16x8 a, bf16x8 b, f32x16 c) { return __builtin_amdgcn_mfma_f32_32x32x16_bf16(a, b, c, 0, 0, 0); }
DI bf16x8 pack8(float a0, float a1, float a2, float a3, float a4, float a5, float a6, float a7) {
  u32x4 u; u.x = pk2(a0, a1); u.y = pk2(a2, a3); u.z = pk2(a4, a5); u.w = pk2(a6, a7);
  return __builtin_bit_cast(bf16x8, u);
}
DI float sigmoidf_(float x) { return 1.f / (1.f + __expf(-x)); }
DI float siluf_(float x) { return x / (1.f + __expf(-x)); }
DI int perm32(int x) { return ((x >> 2) & 3) * 8 + (x >> 4) * 4 + (x & 3); }
DI float wave_sum(float v) {
#pragma unroll
  for (int o = 32; o >= 1; o >>= 1) v += __shfl_xor(v, o);
  return v;
}

DI int win_map(int n) {
  if (n < 1536) return n;
  if (n < 3072) return 2208 + (n - 1536);
  if (n < 3584) return 3744 + (n - 3072);
  if (n < 6656) return 4264 + (n - 3584);
  if (n < 7040) return 1536 + (n - 6656);
  if (n < 7328) return 1920 + (n - 7040);
  if (n < 7336) return 4256 + (n - 7328);
  return -1;
}
DI int gu_map(int n) { int hb = n >> 5, r = n & 31; return r < 16 ? hb * 16 + r : 2816 + hb * 16 + (r - 16); }

constexpr int WT_PER_LAYER = 4692;
DI void w_tile(const Params& p, int item, float* tl) {
  const int tid = otid();
  const int l = item / WT_PER_LAYER; int r = item % WT_PER_LAYER;
  const float* src; const float* rs = nullptr; int K, Nsrc, Nd, mapt = 0; size_t doff;
  if (r < 1856) { src = p.w_in + (size_t)l * 1024 * 7336; K = 1024; Nsrc = 7336; Nd = NIN; mapt = 1; doff = W_IN; }
  else if ((r -= 1856) < 128) { src = p.wod + (size_t)l * 512 * 1024; K = 512; Nsrc = 1024; Nd = 1024; doff = W_OA; }
  else if ((r -= 128) < 128) { src = p.wom + (size_t)l * 512 * 1024; K = 512; Nsrc = 1024; Nd = 1024; doff = W_OB; }
  else if ((r -= 128) < 128) { src = p.wog + (size_t)l * 512 * 1024; K = 512; Nsrc = 1024; Nd = 1024; doff = W_OC; }
  else if ((r -= 128) < 36) { src = p.q_up + (size_t)l * 384 * 384; K = 384; Nsrc = 384; Nd = 384; rs = p.qa_nw + l * 384; doff = W_QUP; }
  else if ((r -= 36) < 48) { src = p.kv_up + (size_t)l * 256 * 768; K = 256; Nsrc = 768; Nd = 768; rs = p.kva_nw + l * 256; doff = W_KVUP; }
  else if ((r -= 48) < 256) { src = p.wout + (size_t)l * 1024 * 1024; K = 1024; Nsrc = 1024; Nd = 1024; doff = W_OUT; }
  else if ((r -= 256) < 1408) { src = p.wgu + (size_t)l * 1024 * 5632; K = 1024; Nsrc = 5632; Nd = 5632; mapt = 2; doff = W_GU; }
  else { r -= 1408; src = p.wdown + (size_t)l * 2816 * 1024; K = 2816; Nsrc = 1024; Nd = 1024; doff = W_DOWN; }
  const int nkt = K >> 6; const int n0 = (r / nkt) * 64, k0 = (r % nkt) * 64;
  bf16_t* dst = (bf16_t*)(p.ws + OFF_W + (size_t)l * W_LAYER + doff);
  __syncthreads();
#pragma unroll
  for (int i = 0; i < 4; ++i) {
    const int idx = tid + 256 * i, rr = idx >> 4, c4 = (idx & 15) * 4;
    const int n = n0 + c4; const int sn = mapt == 1 ? win_map(n) : (mapt == 2 ? gu_map(n) : n);
    f32x4 v = {0.f, 0.f, 0.f, 0.f};
    if (sn >= 0) { v = *(const f32x4*)(src + (size_t)(k0 + rr) * Nsrc + sn); if (rs) { const float sc = rs[k0 + rr]; v[0] *= sc; v[1] *= sc; v[2] *= sc; v[3] *= sc; } }
    tl[rr * 65 + c4] = v[0]; tl[rr * 65 + c4 + 1] = v[1]; tl[rr * 65 + c4 + 2] = v[2]; tl[rr * 65 + c4 + 3] = v[3];
  }
  __syncthreads();
#pragma unroll
  for (int i = 0; i < 2; ++i) {
    const int idx = tid + 256 * i, rr = idx & 63, k8 = (idx >> 6) * 8;
    const float* t0 = tl + k8 * 65 + rr;
    *(bf16x8*)(dst + (size_t)(n0 + rr) * K + k0 + k8) = pack8(t0[0], t0[65], t0[130], t0[195], t0[260], t0[325], t0[390], t0[455]);
  }
}
DI void mod_item(const Params& p, int item, float* red) {
  const int tid = otid(); const int l = item / 96, n0 = (item % 96) * 64;
  const int col = n0 + (tid & 63), kq = tid >> 6;
  const float* w = p.ada_w + (size_t)l * 1024 * 6144;
  float a0 = 0.f, a1 = 0.f;
  for (int k = kq * 256; k < kq * 256 + 256; ++k) { float wv = w[(size_t)k * 6144 + col]; a0 += p.c[k] * wv; a1 += p.c[1024 + k] * wv; }
  __syncthreads();
  red[(kq * 64 + (tid & 63)) * 2] = a0; red[(kq * 64 + (tid & 63)) * 2 + 1] = a1;
  __syncthreads();
  if (tid < 128) {
    int cc = tid & 63, b = tid >> 6; float s = 0.f;
    for (int q = 0; q < 4; ++q) s += red[(q * 64 + cc) * 2 + b];
    float* mod = (float*)(p.ws + OFF_MOD);
    mod[(l * 2 + b) * 6144 + n0 + cc] = s + p.ada_b[l * 6144 + n0 + cc];
  }
}

DI void norm_item(const float* xin, const float* nw, const float* sh, const float* sc, bf16_t* hb, int item) {
  const int lane = otid() & 63, wid = otid() >> 6;
#pragma unroll
  for (int rr = 0; rr < 4; ++rr) {
    const int t = item * 16 + wid * 4 + rr;
    const float* xr = xin + (size_t)t * 1024;
    f32x4 v[4]; float ss = 0.f;
#pragma unroll
    for (int i = 0; i < 4; ++i) { v[i] = *(const f32x4*)(xr + i * 256 + lane * 4); ss += v[i][0] * v[i][0] + v[i][1] * v[i][1] + v[i][2] * v[i][2] + v[i][3] * v[i][3]; }
    ss = wave_sum(ss);
    const float rstd = rsqrtf(ss * (1.f / 1024.f) + EPS);
#pragma unroll
    for (int i = 0; i < 4; ++i) {
      const int c = i * 256 + lane * 4;
      f32x4 w = *(const f32x4*)(nw + c), s1 = *(const f32x4*)(sc + c), s0 = *(const f32x4*)(sh + c);
      float y0 = v[i][0] * rstd * w[0] * (1.f + s1[0]) + s0[0], y1 = v[i][1] * rstd * w[1] * (1.f + s1[1]) + s0[1];
      float y2 = v[i][2] * rstd * w[2] * (1.f + s1[2]) + s0[2], y3 = v[i][3] * rstd * w[3] * (1.f + s1[3]) + s0[3];
      u32x2 o; o.x = pk2(y0, y1); o.y = pk2(y2, y3);
      *(u32x2*)(hb + (size_t)t * 1024 + c) = o;
    }
  }
}

template <int NI>
DI void gemm_kloop(f32x4 (&acc)[4][NI], const bf16_t* __restrict__ A, int lda, const bf16_t* __restrict__ B, int ldb, int K, bf16_t* sA, bf16_t* sB) {
  constexpr int NB = NI / 4 * 4;
  const int tid = otid(), lane = tid & 63, wid = tid >> 6, wr = wid >> 1, wc = wid & 1, lr = lane & 15, lq = lane >> 4;
  bf16x8 ra[4], rb[NB];
  const int nk = K >> 6;
#pragma unroll
  for (int i = 0; i < 4; ++i) { int c = tid + 256 * i, row = c >> 3, kc = (c & 7) * 8; ra[i] = *(const bf16x8*)(A + (size_t)row * lda + kc); }
#pragma unroll
  for (int i = 0; i < NB; ++i) { int c = tid + 256 * i, row = c >> 3, kc = (c & 7) * 8; rb[i] = *(const bf16x8*)(B + (size_t)row * ldb + kc); }
  for (int kt = 0; kt < nk; ++kt) {
    __syncthreads();
#pragma unroll
    for (int i = 0; i < 4; ++i) { int c = tid + 256 * i, row = c >> 3, kc = (c & 7) * 8; *(bf16x8*)(sA + row * 72 + kc) = ra[i]; }
#pragma unroll
    for (int i = 0; i < NB; ++i) { int c = tid + 256 * i, row = c >> 3, kc = (c & 7) * 8; *(bf16x8*)(sB + row * 72 + kc) = rb[i]; }
    __syncthreads();
    if (kt + 1 < nk) {
      const int k0 = (kt + 1) * 64;
#pragma unroll
      for (int i = 0; i < 4; ++i) { int c = tid + 256 * i, row = c >> 3, kc = (c & 7) * 8; ra[i] = *(const bf16x8*)(A + (size_t)row * lda + k0 + kc); }
#pragma unroll
      for (int i = 0; i < NB; ++i) { int c = tid + 256 * i, row = c >> 3, kc = (c & 7) * 8; rb[i] = *(const bf16x8*)(B + (size_t)row * ldb + k0 + kc); }
    }
#pragma unroll
    for (int ks = 0; ks < 2; ++ks) {
      bf16x8 af[4];
#pragma unroll
      for (int mi = 0; mi < 4; ++mi) af[mi] = *(const bf16x8*)(sA + (wr * 64 + mi * 16 + lr) * 72 + ks * 32 + lq * 8);
#pragma unroll
      for (int nh = 0; nh < NI / 4; ++nh) {
        bf16x8 bfr[4];
#pragma unroll
        for (int ni = 0; ni < 4; ++ni) bfr[ni] = *(const bf16x8*)(sB + (wc * (NI * 16) + (nh * 4 + ni) * 16 + lr) * 72 + ks * 32 + lq * 8);
#pragma unroll
        for (int mi = 0; mi < 4; ++mi)
#pragma unroll
          for (int ni = 0; ni < 4; ++ni) acc[mi][nh * 4 + ni] = mfma16(bfr[ni], af[mi], acc[mi][nh * 4 + ni]);
      }
    }
  }
}
template <int NI>
DI void zero_acc(f32x4 (&acc)[4][NI]) {
#pragma unroll
  for (int a = 0; a < 4; ++a)
#pragma unroll
    for (int b = 0; b < NI; ++b) acc[a][b] = (f32x4){0.f, 0.f, 0.f, 0.f};
}
#define EPI_LOOP(body)                                                                                       \
  {                                                                                                          \
    const int lane_ = otid() & 63, wid_ = otid() >> 6;                                             \
    _Pragma("unroll") for (int mi = 0; mi < 4; ++mi) _Pragma("unroll") for (int ni = 0; ni < NI_; ++ni) {    \
      const int t = m0 + (wid_ >> 1) * 64 + mi * 16 + (lane_ & 15);                                          \
      const int cl = (wid_ & 1) * (NI_ * 16) + ni * 16 + (lane_ >> 4) * 4;             \
      f32x4 v = acc[mi][ni];                                                                                 \
      body                                                                                                   \
    }                                                                                                        \
  }
DI void st_bf4(bf16_t* dst, f32x4 v) { u32x2 o; o.x = pk2(v[0], v[1]); o.y = pk2(v[2], v[3]); *(u32x2*)dst = o; }

DI void inproj_item(const Params& p, int l, int item, bf16_t* lds) {
  constexpr int NI_ = 8;
  const int mt = item / 29, nt = item % 29; const int m0 = mt * 128, n0 = nt * 256;
  const bf16_t* A = (const bf16_t*)(p.ws + OFF_HB) + (size_t)m0 * 1024;
  const bf16_t* B = (const bf16_t*)(p.ws + OFF_W + (size_t)l * W_LAYER + W_IN) + (size_t)n0 * 1024;
  f32x4 acc[4][8]; zero_acc<8>(acc);
  gemm_kloop<8>(acc, A, 1024, B, 1024, 1024, lds, lds + 128 * 72);
  bf16_t* dst; int ld, cb;
  if (nt < 6) { dst = (bf16_t*)(p.ws + OFF_RA); ld = 1536; cb = n0; }
  else if (nt < 12) { dst = (bf16_t*)(p.ws + OFF_RC); ld = 1536; cb = n0 - 1536; }
  else if (nt < 14) { dst = (bf16_t*)(p.ws + OFF_RZ); ld = 512; cb = n0 - 3072; }
  else if (nt < 26) { dst = (bf16_t*)(p.ws + OFF_RG); ld = 3072; cb = n0 - 3584; }
  else { dst = (bf16_t*)(p.ws + OFF_RB); ld = 768; cb = n0 - 6656; }
  float* BA = (float*)(p.ws + OFF_BA);
  if (nt < 4) {
    const int lane = otid() & 63, wid = otid() >> 6, lr = lane & 15, lq = lane >> 4;
    const float* nw = (nt < 2 ? p.dqn : p.dkn) + l * 64;
    const float sc = nt < 2 ? 0.125f * LOG2E : 1.f;
#pragma unroll
    for (int mi = 0; mi < 4; ++mi) {
      const int t = m0 + (wid >> 1) * 64 + mi * 16 + lr;
#pragma unroll
      for (int grp = 0; grp < 2; ++grp) {
        float ss = 0.f;
#pragma unroll
        for (int n4 = 0; n4 < 4; ++n4) { f32x4 v = acc[mi][grp * 4 + n4]; ss += v[0] * v[0] + v[1] * v[1] + v[2] * v[2] + v[3] * v[3]; }
        ss += __shfl_xor(ss, 16); ss += __shfl_xor(ss, 32);
        const float rstd = rsqrtf(ss * (1.f / 64.f) + EPS) * sc;
#pragma unroll
        for (int n4 = 0; n4 < 4; ++n4) {
          f32x4 v = acc[mi][grp * 4 + n4]; f32x4 w = *(const f32x4*)(nw + n4 * 16 + lq * 4);
          v[0] *= rstd * w[0]; v[1] *= rstd * w[1]; v[2] *= rstd * w[2]; v[3] *= rstd * w[3];
          st_bf4(dst + (size_t)t * ld + cb + (wid & 1) * 128 + (grp * 4 + n4) * 16 + lq * 4, v);
        }
      }
    }
  } else {
    EPI_LOOP({
      st_bf4(dst + (size_t)t * ld + cb + cl, v);
      if (nt == 28) { int nn = n0 + cl; if (nn >= 7328 && nn < 7336) *(f32x4*)(BA + (size_t)t * 8 + (nn - 7328)) = v; }
    })
  }
}
DI void upproj_item(const Params& p, int l, int item, bf16_t* lds) {
  constexpr int NI_ = 4;
  f32x4 acc[4][4]; zero_acc<4>(acc);
  const bf16_t* RB = (const bf16_t*)(p.ws + OFF_RB);
  if (item < 384) {
    const int mt = item / 3, nt = item % 3, m0 = mt * 128, n0 = nt * 128;
    gemm_kloop<4>(acc, RB + (size_t)m0 * 768, 768, (const bf16_t*)(p.ws + OFF_W + (size_t)l * W_LAYER + W_QUP) + (size_t)n0 * 384, 384, 384, lds, lds + 128 * 72);
    bf16_t* dst = (bf16_t*)(p.ws + OFF_YQ);
    EPI_LOOP({ st_bf4(dst + (size_t)t * 384 + n0 + cl, v); })
  } else {
    item -= 384; const int mt = item / 6, nt = item % 6, m0 = mt * 128, n0 = nt * 128;
    gemm_kloop<4>(acc, RB + (size_t)m0 * 768 + 384, 768, (const bf16_t*)(p.ws + OFF_W + (size_t)l * W_LAYER + W_KVUP) + (size_t)n0 * 256, 256, 256, lds, lds + 128 * 72);
    bf16_t* dst = (bf16_t*)(p.ws + OFF_HB);
    EPI_LOOP({ st_bf4(dst + (size_t)t * 768 + n0 + cl, v); })
  }
}
DI void merge_item(const Params& p, int l, int item, bf16_t* lds) {
  constexpr int NI_ = 4;
  const int mt = item >> 3, nt = item & 7, m0 = mt * 128, n0 = nt * 128;
  u32x2 mg[4][4];
  const bf16_t* RG = (const bf16_t*)(p.ws + OFF_RG);
  bf16_t* dst = (bf16_t*)(p.ws + OFF_HB);
  for (int br = 0; br < 3; ++br) {
    f32x4 acc[4][4]; zero_acc<4>(acc);
    const bf16_t* A; int lda; size_t wo;
    if (br == 0) { A = (const bf16_t*)(p.ws + OFF_RA); lda = 1536; wo = W_OA; }
    else if (br == 1) { A = (const bf16_t*)(p.ws + OFF_CQ); lda = 512; wo = W_OB; }
    else { A = (const bf16_t*)(p.ws + OFF_CQ + 32 * MiB); lda = 512; wo = W_OC; }
    gemm_kloop<4>(acc, A + (size_t)m0 * lda, lda, (const bf16_t*)(p.ws + OFF_W + (size_t)l * W_LAYER + wo) + (size_t)n0 * 512, 512, 512, lds, lds + 128 * 72);
    EPI_LOOP({
      u32x2 g = *(const u32x2*)(RG + (size_t)t * 3072 + br * 1024 + n0 + cl);
      f32x4 o; o[0] = sigmoidf_(bflo(g.x)) * v[0]; o[1] = sigmoidf_(bfhi(g.x)) * v[1]; o[2] = sigmoidf_(bflo(g.y)) * v[2]; o[3] = sigmoidf_(bfhi(g.y)) * v[3];
      if (br > 0) { u32x2 pm = mg[mi][ni]; o[0] += bflo(pm.x); o[1] += bfhi(pm.x); o[2] += bflo(pm.y); o[3] += bfhi(pm.y); }
      u32x2 pk; pk.x = pk2(o[0], o[1]); pk.y = pk2(o[2], o[3]);
      mg[mi][ni] = pk;
      if (br == 2) *(u32x2*)(dst + (size_t)t * 1024 + n0 + cl) = pk;
    })
  }
}
DI void resid_gemm_item(const bf16_t* A, int lda, const bf16_t* W, int K, const float* xin, float* xout, const float* gate, int item, bf16_t* lds) {
  constexpr int NI_ = 8;
  const int mt = item >> 2, nt = item & 3, m0 = mt * 128, n0 = nt * 256;
  f32x4 acc[4][8]; zero_acc<8>(acc);
  gemm_kloop<8>(acc, A + (size_t)m0 * lda, lda, W + (size_t)n0 * K, K, K, lds, lds + 128 * 72);
  EPI_LOOP({
    const int c = n0 + cl;
    f32x4 xo = *(const f32x4*)(xin + (size_t)t * 1024 + c); f32x4 g = *(const f32x4*)(gate + c);
    xo[0] += g[0] * v[0]; xo[1] += g[1] * v[1]; xo[2] += g[2] * v[2]; xo[3] += g[3] * v[3];
    *(f32x4*)(xout + (size_t)t * 1024 + c) = xo;
  })
}
DI void ffn1_item(const Params& p, int l, int item, bf16_t* lds) {
  const int mt = item / 22, nt = item % 22, m0 = mt * 128, n0 = nt * 256;
  f32x4 acc[4][8]; zero_acc<8>(acc);
  gemm_kloop<8>(acc, (const bf16_t*)(p.ws + OFF_HB) + (size_t)m0 * 1024, 1024, (const bf16_t*)(p.ws + OFF_W + (size_t)l * W_LAYER + W_GU) + (size_t)n0 * 1024, 1024, 1024, lds, lds + 128 * 72);
  bf16_t* hid = (bf16_t*)(p.ws + OFF_RG);
  const int lane = otid() & 63, wid = otid() >> 6;
#pragma unroll
  for (int mi = 0; mi < 4; ++mi)
#pragma unroll
    for (int np = 0; np < 4; ++np) {
      const int t = m0 + (wid >> 1) * 64 + mi * 16 + (lane & 15);
      const int hcol = (((n0 + (wid & 1) * 128) >> 5) + np) * 16 + (lane >> 4) * 4;
      f32x4 g = acc[mi][np * 2], u = acc[mi][np * 2 + 1], o;
#pragma unroll
      for (int r = 0; r < 4; ++r) o[r] = siluf_(g[r]) * u[r];
      st_bf4(hid + (size_t)t * FH + hcol, o);
    }
}

DI void vt_transpose(const bf16_t* src, int ld, const float* srs, bf16_t* dstVt, int t0, bf16_t* sT) {
  const int tid = otid();
  __syncthreads();
  {
    const int row = tid >> 4, col8 = (tid & 15) * 8;
    u32x4 v = *(const u32x4*)(src + (size_t)row * ld + col8);
    const float sc = srs ? srs[row] : 1.f;
    unsigned w[4] = {v.x, v.y, v.z, v.w};
#pragma unroll
    for (int j = 0; j < 4; ++j) { sT[row * 130 + col8 + 2 * j] = f2bf(bflo(w[j]) * sc); sT[row * 130 + col8 + 2 * j + 1] = f2bf(bfhi(w[j]) * sc); }
  }
  __syncthreads();
  const int p16 = tid & 15, half = p16 >> 3, jj = p16 & 7, dg = tid >> 4;
  const int key = (jj >> 2) * 8 + half * 4 + (jj & 3);
#pragma unroll
  for (int i = 0; i < 8; ++i) { const int d = dg * 8 + i; dstVt[(size_t)d * TT + t0 + p16] = sT[key * 130 + d]; }
}

DI void prep_ew_item(const Params& p, int l, int item, bf16_t* lds) {
  const int lane = otid() & 63, wid = otid() >> 6;
  const int t0 = item * 16;
  bf16_t* RA = (bf16_t*)(p.ws + OFF_RA);
  const bf16_t* RC = (const bf16_t*)(p.ws + OFF_RC);
  bf16_t* CQ = (bf16_t*)(p.ws + OFF_CQ);
  const float* BA = (const float*)(p.ws + OFF_BA); float* GB = BA ? (float*)(p.ws + OFF_BA + 512 * 1024) : nullptr;
  const int tw = t0 + wid * 4;
#pragma unroll
  for (int part = 0; part < 3; ++part) {
    const int ch = part * 512 + lane * 8;
    f32x4 cw[4][2];
#pragma unroll
    for (int i = 0; i < 4; ++i) { const float* cp = p.convw + ((size_t)l * 4 + i) * 1536 + ch; cw[i][0] = *(const f32x4*)cp; cw[i][1] = *(const f32x4*)(cp + 4); }
    u32x4 xr[7];
#pragma unroll
    for (int j = 0; j < 7; ++j) {
      const int ts = tw - 3 + j;
      xr[j] = (u32x4){0u, 0u, 0u, 0u};
      if (ts >= 0) xr[j] = *(const u32x4*)(RC + (size_t)ts * 1536 + ch);
    }
#pragma unroll
    for (int rr = 0; rr < 4; ++rr) {
      float a[8];
#pragma unroll
      for (int j = 0; j < 8; ++j) a[j] = 0.f;
#pragma unroll
      for (int i = 0; i < 4; ++i) {
        const u32x4 v = xr[rr + i]; const f32x4 c0 = cw[i][0], c1 = cw[i][1];
        a[0] += bflo(v.x) * c0[0]; a[1] += bfhi(v.x) * c0[1]; a[2] += bflo(v.y) * c0[2]; a[3] += bfhi(v.y) * c0[3];
        a[4] += bflo(v.z) * c1[0]; a[5] += bfhi(v.z) * c1[1]; a[6] += bflo(v.w) * c1[2]; a[7] += bfhi(v.w) * c1[3];
      }
      float ss = 0.f;
#pragma unroll
      for (int j = 0; j < 8; ++j) { a[j] = siluf_(a[j]); ss += a[j] * a[j]; }
      float mul = 1.f;
      if (part < 2) {
        ss += __shfl_xor(ss, 1); ss += __shfl_xor(ss, 2); ss += __shfl_xor(ss, 4); ss += __shfl_xor(ss, 8);
        mul = rsqrtf(ss + EPS) * (part == 0 ? 0.08838834764831845f : 1.f);
      }
      u32x4 o; o.x = pk2(a[0] * mul, a[1] * mul); o.y = pk2(a[2] * mul, a[3] * mul); o.z = pk2(a[4] * mul, a[5] * mul); o.w = pk2(a[6] * mul, a[7] * mul);
      *(u32x4*)(CQ + (size_t)(tw + rr) * 1536 + ch) = o;
    }
  }
  if (lane < 32) {
    const int t = tw + (lane >> 3), cidx = lane & 7;
    float r;
    if (cidx < 4) r = sigmoidf_(BA[(size_t)t * 8 + cidx]);
    else { int h = cidx - 4; float xx = BA[(size_t)t * 8 + cidx] + p.dtb[l * 4 + h]; float sp = xx > 20.f ? xx : __logf(1.f + __expf(xx)); r = -__expf(p.alog[l * 4 + h]) * sp; }
    GB[(size_t)t * 8 + cidx] = r;
  }
  for (int h = 0; h < 4; ++h)
    vt_transpose(RA + (size_t)t0 * 1536 + 1024 + h * 128, 1536, nullptr, (bf16_t*)(p.ws + OFF_VTA) + (size_t)h * 128 * TT, t0, lds);
}

DI void bpost_item(const Params& p, int l, int b, int item, bf16_t* lds) {
  const int lane = otid() & 63, wid = otid() >> 6;
  const int t0 = item * 16;
  const bf16_t* RB = (const bf16_t*)(p.ws + OFF_RB);
  const bf16_t* YQ = (const bf16_t*)(p.ws + OFF_YQ);
  const bf16_t* YKV = (const bf16_t*)(p.ws + OFF_HB);
  bf16_t* QB = (bf16_t*)(p.ws + OFF_QB); bf16_t* KB = (bf16_t*)(p.ws + OFF_KB);
  float* srs = (float*)(lds + 64 * 130);
  float invf = 1.000000000e+00f;
  {
    const int fi = lane & 15;
    invf = (fi == 1) ? 5.623413324e-01f : invf;
    invf = (fi == 2) ? 3.162277639e-01f : invf;
    invf = (fi == 3) ? 1.778279394e-01f : invf;
    invf = (fi == 4) ? 1.000000015e-01f : invf;
    invf = (fi == 5) ? 5.623413250e-02f : invf;
    invf = (fi == 6) ? 3.162277490e-02f : invf;
    invf = (fi == 7) ? 1.778279431e-02f : invf;
    invf = (fi == 8) ? 9.999999776e-03f : invf;
    invf = (fi == 9) ? 5.623413250e-03f : invf;
    invf = (fi == 10) ? 3.162277630e-03f : invf;
    invf = (fi == 11) ? 1.778279431e-03f : invf;
    invf = (fi == 12) ? 1.000000047e-03f : invf;
    invf = (fi == 13) ? 5.623413017e-04f : invf;
    invf = (fi == 14) ? 3.162277571e-04f : invf;
    invf = (fi == 15) ? 1.778279402e-04f : invf;
  }
  __syncthreads();
#pragma unroll
  for (int rr = 0; rr < 4; ++rr) {
    const int t = t0 + wid * 4 + rr;
    float ssq = 0.f, sskv = 0.f;
    {
      const bf16_t* q = RB + (size_t)t * 768;
#pragma unroll
      for (int j = 0; j < 6; ++j) { float v = bf2f(q[lane + 64 * j]); ssq += v * v; }
#pragma unroll
      for (int j = 0; j < 4; ++j) { float v = bf2f(q[384 + lane + 64 * j]); sskv += v * v; }
    }
    ssq = wave_sum(ssq); sskv = wave_sum(sskv);
    const float rq = rsqrtf(ssq * (1.f / 384.f) + EPS), rkv = rsqrtf(sskv * (1.f / 256.f) + EPS);
    if (lane == 0) srs[wid * 4 + rr] = rkv;
    const float ang = (float)p.pos[(size_t)b * TT + t] * invf;
    float sn, cs; sincosf(ang, &sn, &cs);
    const float kr = lane < 32 ? bf2f(RB[(size_t)t * 768 + 640 + lane]) : 0.f;
#pragma unroll
    for (int h = 0; h < 4; ++h) {
#pragma unroll
      for (int qk = 0; qk < 2; ++qk) {
        float e0, e1;
        if (qk == 0) { e0 = bf2f(YQ[(size_t)t * 384 + h * 96 + lane]) * rq; e1 = lane < 32 ? bf2f(YQ[(size_t)t * 384 + h * 96 + 64 + lane]) * rq : 0.f; }
        else { e0 = bf2f(YKV[(size_t)t * 768 + h * 192 + lane]) * rkv; e1 = kr; }
        float ss = wave_sum(e0 * e0 + e1 * e1);
        const float r = rsqrtf(ss * (1.f / 96.f) + EPS);
        const float* nw = (qk == 0 ? p.mqn : p.mkn) + l * 96;
        float n0 = e0 * r * nw[lane];
        float n1 = lane < 32 ? e1 * r * nw[64 + lane] : 0.f;
        float pr = __shfl_xor(n1, 16);
        float ro = (lane < 16) ? (n1 * cs - pr * sn) : (n1 * cs + pr * sn);
        const float sc = qk == 0 ? 0.10206207261596577f * LOG2E : 1.f;
        bf16_t* dst = (qk == 0 ? QB : KB) + (size_t)t * 384 + h * 96;
        dst[lane] = f2bf(n0 * sc);
        if (lane < 32) dst[64 + lane] = f2bf(ro * sc);
      }
    }
  }
  for (int h = 0; h < 4; ++h)
    vt_transpose(YKV + (size_t)t0 * 768 + h * 192 + 64, 768, srs, (bf16_t*)(p.ws + OFF_VTB) + (size_t)h * 128 * TT, t0, lds);
  __syncthreads();
}

DI void gdnprep_item(const Params& p, int item, unsigned char* ldsb) {
  const int tid = otid(), lane = tid & 63, wid = tid >> 6, lr = lane & 15, lq = lane >> 4;
  const int n = item >> 2, h = item & 3, t0 = n * 64;
  bf16_t* sK = (bf16_t*)ldsb; bf16_t* sQ = sK + 64 * 136; float* Lm = (float*)(ldsb + 2 * 64 * 136 * 2);
  float* sgc = Lm + 64 * 64; float* sbeta = sgc + 64;
  const bf16_t* CQ = (const bf16_t*)(p.ws + OFF_CQ);
  const float* GB = (const float*)(p.ws + OFF_BA + 512 * 1024);
  bf16_t* Wp = (bf16_t*)(p.ws + OFF_RC) + (size_t)item * 8192;
  bf16_t* Qp = (bf16_t*)(p.ws + OFF_RC + 16 * MiB) + (size_t)item * 8192;
  bf16_t* KTp = (bf16_t*)(p.ws + OFF_RC + 32 * MiB) + (size_t)item * 8192;
  bf16_t* UTp = (bf16_t*)(p.ws + OFF_UT) + (size_t)item * 8192;
  bf16_t* ATp = (bf16_t*)(p.ws + OFF_ATT) + (size_t)item * 4096;
  float* GCp = (float*)(p.ws + OFF_GC) + (size_t)item * 64;
  __syncthreads();
  if (tid < 64) {
    float g = GB[(size_t)(t0 + tid) * 8 + 4 + h];
#pragma unroll
    for (int o = 1; o < 64; o <<= 1) { float nb = __shfl_up(g, o); if (lane >= o) g += nb; }
    sgc[tid] = g; sbeta[tid] = GB[(size_t)(t0 + tid) * 8 + h]; GCp[tid] = g;
  }
#pragma unroll
  for (int e = 0; e < 4; ++e) {
    int c = tid + 256 * e, row = c >> 4, c8 = (c & 15) * 8;
    *(bf16x8*)(sQ + row * 136 + c8) = *(const bf16x8*)(CQ + (size_t)(t0 + row) * 1536 + h * 128 + c8);
    *(bf16x8*)(sK + row * 136 + c8) = *(const bf16x8*)(CQ + (size_t)(t0 + row) * 1536 + 512 + h * 128 + c8);
  }
  __syncthreads();
  {
    bf16x8 ak[4], aq[4];
#pragma unroll
    for (int s = 0; s < 4; ++s) { ak[s] = *(const bf16x8*)(sK + (wid * 16 + lr) * 136 + s * 32 + lq * 8); aq[s] = *(const bf16x8*)(sQ + (wid * 16 + lr) * 136 + s * 32 + lq * 8); }
#pragma unroll
    for (int nt = 0; nt < 4; ++nt) {
      f32x4 kk = {0.f, 0.f, 0.f, 0.f}, qk = {0.f, 0.f, 0.f, 0.f};
#pragma unroll
      for (int s = 0; s < 4; ++s) { bf16x8 bk = *(const bf16x8*)(sK + (nt * 16 + lr) * 136 + s * 32 + lq * 8); kk = mfma16(ak[s], bk, kk); qk = mfma16(aq[s], bk, qk); }
      const int j = nt * 16 + lr; const float gj = sgc[j];
#pragma unroll
      for (int r = 0; r < 4; ++r) {
        const int i = wid * 16 + lq * 4 + r;
        const float dec = (i >= j) ? __expf(sgc[i] - gj) : 0.f;
        Lm[i * 64 + j] = (i > j) ? sbeta[i] * kk[r] * dec : 0.f;
        ATp[i * 64 + (j & ~31) + perm32(j & 31)] = f2bf(qk[r] * dec);
      }
    }
  }
  __syncthreads();
  {
    const int c = tid & 127; const bool isw = tid >= 128;
    float x[64];
#pragma unroll
    for (int i = 0; i < 64; ++i) {
      if (isw) x[i] = bf2f(sK[i * 136 + c]) * sbeta[i] * __expf(sgc[i]);
      else x[i] = bf2f(CQ[(size_t)(t0 + i) * 1536 + 1024 + h * 128 + c]) * sbeta[i];
    }
#pragma unroll
    for (int i = 1; i < 64; ++i) {
      float a = x[i];
#pragma unroll
      for (int j4 = 0; j4 < (i + 3) / 4; ++j4) {
        f32x4 Lv = *(const f32x4*)(Lm + i * 64 + j4 * 4);
#pragma unroll
        for (int e = 0; e < 4; ++e) if (j4 * 4 + e < i) a -= Lv[e] * x[j4 * 4 + e];
      }
      x[i] = a;
      if ((i & 3) == 3) __builtin_amdgcn_sched_barrier(0);
    }
    if (!isw) {
#pragma unroll
      for (int i8 = 0; i8 < 8; ++i8)
        *(bf16x8*)(UTp + c * 64 + i8 * 8) = pack8(x[i8 * 8], x[i8 * 8 + 1], x[i8 * 8 + 2], x[i8 * 8 + 3], x[i8 * 8 + 4], x[i8 * 8 + 5], x[i8 * 8 + 6], x[i8 * 8 + 7]);
    } else {
      const int pc = (c & ~31) + perm32(c & 31);
#pragma unroll
      for (int i = 0; i < 64; ++i) Wp[i * 128 + pc] = f2bf(-x[i]);
    }
  }
  for (int e = 0; e < 32; ++e) {
    int idx = tid + 256 * e;
    { int i = idx >> 7, d = idx & 127; Qp[i * 128 + (d & ~31) + perm32(d & 31)] = sQ[i * 136 + d]; }
    { int d = idx >> 6, i = idx & 63; KTp[d * 64 + (i & ~31) + perm32(i & 31)] = sK[i * 136 + d]; }
  }
  __syncthreads();
}

DI void scan_item(const Params& p, int sidx, unsigned char* ldsb) {
  const int tid = otid(), lane = tid & 63, wid = tid >> 6, lr = lane & 15, lq = lane >> 4;
  const int h = sidx >> 1, cb = (sidx & 1) * 4 + wid, c0 = cb * 16;
  const bf16_t* Wb = (const bf16_t*)(p.ws + OFF_RC);
  const bf16_t* KTb = (const bf16_t*)(p.ws + OFF_RC + 32 * MiB);
  const bf16_t* UTb = (const bf16_t*)(p.ws + OFF_UT);
  const float* GCb = (const float*)(p.ws + OFF_GC);
  bf16x8* SN = (bf16x8*)(p.ws + OFF_HB);
  bf16x8* VN = (bf16x8*)(p.ws + OFF_CQ + 16 * MiB);
  bf16_t* sW = (bf16_t*)ldsb; bf16_t* sKT = sW + 64 * 136;
  float* sGC = (float*)(ldsb + (64 * 136 + 128 * 72) * 2);
  bf16x8 rgA[8], rgB[8]; u32x2 unA[4], unB[4]; f32x4 gnA, gnB;
#define SCAN_ISSUE(rg, un, gn, nn)                                                                                       \
  {                                                                                                                      \
    const size_t item_ = (size_t)(nn) * 4 + h;                                                                           \
    _Pragma("unroll") for (int i = 0; i < 4; ++i) {                                                                      \
      const int c = tid + 256 * i;                                                                                       \
      rg[i] = *(const bf16x8*)(Wb + item_ * 8192 + (c >> 4) * 128 + (c & 15) * 8);                                       \
      rg[4 + i] = *(const bf16x8*)(KTb + item_ * 8192 + (c >> 3) * 64 + (c & 7) * 8);                                    \
    }                                                                                                                    \
    _Pragma("unroll") for (int mi = 0; mi < 4; ++mi) un[mi] = *(const u32x2*)(UTb + item_ * 8192 + (c0 + lr) * 64 + mi * 16 + lq * 4); \
    gn = *(const f32x4*)(GCb + item_ * 64 + (tid & 15) * 4);                                                             \
  }
#define SCAN_STEP(rg, un, gn, n)                                                                                         \
  {                                                                                                                      \
    __syncthreads();                                                                                                     \
    _Pragma("unroll") for (int i = 0; i < 4; ++i) {                                                                      \
      const int c = tid + 256 * i;                                                                                       \
      *(bf16x8*)(sW + (c >> 4) * 136 + (c & 15) * 8) = rg[i];                                                            \
      *(bf16x8*)(sKT + (c >> 3) * 72 + (c & 7) * 8) = rg[4 + i];                                                         \
    }                                                                                                                    \
    if (tid < 16) *(f32x4*)(sGC + tid * 4) = gn;                                                                         \
    __syncthreads();                                                                                                     \
    f32x4 V[4];                                                                                                          \
    _Pragma("unroll") for (int mi = 0; mi < 4; ++mi) V[mi] = (f32x4){bflo(un[mi].x), bfhi(un[mi].x), bflo(un[mi].y), bfhi(un[mi].y)}; \
    if ((n) + 2 < 256) SCAN_ISSUE(rg, un, gn, (n) + 2)                                                                   \
    f32x4 gcv[4];                                                                                                        \
    _Pragma("unroll") for (int mi = 0; mi < 4; ++mi) gcv[mi] = *(const f32x4*)(sGC + mi * 16 + lq * 4);                  \
    const float gl = sGC[63];                                                                                            \
    const size_t item = (size_t)(n) * 4 + h;                                                                             \
    bf16x8 bs[4];                                                                                                        \
    _Pragma("unroll") for (int s_ = 0; s_ < 4; ++s_) {                                                                   \
      bs[s_] = pack8(S[2 * s_][0], S[2 * s_][1], S[2 * s_][2], S[2 * s_][3], S[2 * s_ + 1][0], S[2 * s_ + 1][1], S[2 * s_ + 1][2], S[2 * s_ + 1][3]); \
      SN[((item * 8 + cb) * 4 + s_) * 64 + lane] = bs[s_];                                                               \
    }                                                                                                                    \
    bf16x8 wf[2][4];     \
    _Pragma("unroll") for (int mi = 0; mi < 4; ++mi) wf[0][mi] = *(const bf16x8*)(sW + (mi * 16 + lr) * 136 + lq * 8);  \
    _Pragma("unroll") for (int s_ = 0; s_ < 4; ++s_) {                                                                   \
      if (s_ < 3) { _Pragma("unroll") for (int mi = 0; mi < 4; ++mi) wf[(s_ + 1) & 1][mi] = *(const bf16x8*)(sW + (mi * 16 + lr) * 136 + (s_ + 1) * 32 + lq * 8); } \
      else { _Pragma("unroll") for (int mi = 0; mi < 4; ++mi) wf[0][mi] = *(const bf16x8*)(sKT + (mi * 16 + lr) * 72 + lq * 8); } \
      __builtin_amdgcn_sched_barrier(0);                                                                                 \
      _Pragma("unroll") for (int mi = 0; mi < 4; ++mi) V[mi] = mfma16(wf[s_ & 1][mi], bs[s_], V[mi]);                    \
      __builtin_amdgcn_sched_barrier(0);                                                                                 \
    }                                                                                                                    \
    bf16x8 bvs[2];                                                                                                       \
    _Pragma("unroll") for (int s2 = 0; s2 < 2; ++s2) {                                                                   \
      f32x4 a = V[2 * s2], b = V[2 * s2 + 1], ga = gcv[2 * s2], gb = gcv[2 * s2 + 1];                                    \
      VN[((item * 8 + cb) * 2 + s2) * 64 + lane] = pack8(a[0], a[1], a[2], a[3], b[0], b[1], b[2], b[3]);                \
      bvs[s2] = pack8(a[0] * __expf(gl - ga[0]), a[1] * __expf(gl - ga[1]), a[2] * __expf(gl - ga[2]), a[3] * __expf(gl - ga[3]), \
                      b[0] * __expf(gl - gb[0]), b[1] * __expf(gl - gb[1]), b[2] * __expf(gl - gb[2]), b[3] * __expf(gl - gb[3])); \
    }                                                                                                                    \
    const float egl = __expf(gl);                                                                                        \
    _Pragma("unroll") for (int mt = 0; mt < 8; ++mt) S[mt] = S[mt] * egl;                                                \
        \
    _Pragma("unroll") for (int q = 0; q < 4; ++q) {                                                                      \
      if (q < 3) { _Pragma("unroll") for (int i = 0; i < 4; ++i) wf[(q + 1) & 1][i] = *(const bf16x8*)(sKT + ((((q + 1) & 1) * 4 + i) * 16 + lr) * 72 + ((q + 1) >> 1) * 32 + lq * 8); } \
      __builtin_amdgcn_sched_barrier(0);                                                                                 \
      _Pragma("unroll") for (int i = 0; i < 4; ++i) S[(q & 1) * 4 + i] = mfma16(wf[q & 1][i], bvs[q >> 1], S[(q & 1) * 4 + i]); \
      __builtin_amdgcn_sched_barrier(0);                                                                                 \
    }                                                                                                                    \
  }
  f32x4 S[8];
#pragma unroll
  for (int i = 0; i < 8; ++i) S[i] = (f32x4){0.f, 0.f, 0.f, 0.f};
  SCAN_ISSUE(rgA, unA, gnA, 0)
  SCAN_ISSUE(rgB, unB, gnB, 1)
  for (int n = 0; n < 256; n += 2) {
    SCAN_STEP(rgA, unA, gnA, n)
    SCAN_STEP(rgB, unB, gnB, n + 1)
  }
#undef SCAN_ISSUE
#undef SCAN_STEP
}
DI void gdnout_item(const Params& p, int l, int item, float* red  ) {
  const int tid = otid(), lane = tid & 63, wid = tid >> 6, lr = lane & 15, lq = lane >> 4;
  const int n = item >> 2, h = item & 3, t0 = n * 64;
  const bf16_t* Qp = (const bf16_t*)(p.ws + OFF_RC + 16 * MiB) + (size_t)item * 8192;
  const bf16_t* ATp = (const bf16_t*)(p.ws + OFF_ATT) + (size_t)item * 4096;
  const float* GCp = (const float*)(p.ws + OFF_GC) + (size_t)item * 64;
  const bf16x8* SN = (const bf16x8*)(p.ws + OFF_HB);
  const bf16x8* VN = (const bf16x8*)(p.ws + OFF_CQ + 16 * MiB);
  const bf16_t* RZ = (const bf16_t*)(p.ws + OFF_RZ);
  bf16_t* OC = (bf16_t*)(p.ws + OFF_CQ + 32 * MiB);
  f32x4 O[4][2];
#pragma unroll
  for (int mi = 0; mi < 4; ++mi) { O[mi][0] = (f32x4){0.f, 0.f, 0.f, 0.f}; O[mi][1] = (f32x4){0.f, 0.f, 0.f, 0.f}; }
#pragma unroll
  for (int s = 0; s < 4; ++s) {
    bf16x8 b0 = SN[(((size_t)item * 8 + 2 * wid) * 4 + s) * 64 + lane], b1 = SN[(((size_t)item * 8 + 2 * wid + 1) * 4 + s) * 64 + lane];
#pragma unroll
    for (int mi = 0; mi < 4; ++mi) {
      bf16x8 aq = *(const bf16x8*)(Qp + (mi * 16 + lr) * 128 + s * 32 + lq * 8);
      O[mi][0] = mfma16(aq, b0, O[mi][0]); O[mi][1] = mfma16(aq, b1, O[mi][1]);
    }
  }
#pragma unroll
  for (int mi = 0; mi < 4; ++mi) {
    f32x4 g = *(const f32x4*)(GCp + mi * 16 + lq * 4);
#pragma unroll
    for (int r = 0; r < 4; ++r) { float e = __expf(g[r]); O[mi][0][r] *= e; O[mi][1][r] *= e; }
  }
#pragma unroll
  for (int s2 = 0; s2 < 2; ++s2) {
    bf16x8 b0 = VN[(((size_t)item * 8 + 2 * wid) * 2 + s2) * 64 + lane], b1 = VN[(((size_t)item * 8 + 2 * wid + 1) * 2 + s2) * 64 + lane];
#pragma unroll
    for (int mi = 0; mi < 4; ++mi) {
      bf16x8 aa = *(const bf16x8*)(ATp + (mi * 16 + lr) * 64 + s2 * 32 + lq * 8);
      O[mi][0] = mfma16(aa, b0, O[mi][0]); O[mi][1] = mfma16(aa, b1, O[mi][1]);
    }
  }
  __syncthreads();
#pragma unroll
  for (int mi = 0; mi < 4; ++mi)
#pragma unroll
    for (int r = 0; r < 4; ++r) {
      float ss = O[mi][0][r] * O[mi][0][r] + O[mi][1][r] * O[mi][1][r];
      ss += __shfl_xor(ss, 1); ss += __shfl_xor(ss, 2); ss += __shfl_xor(ss, 4); ss += __shfl_xor(ss, 8);
      if (lr == 0) red[wid * 64 + mi * 16 + lq * 4 + r] = ss;
    }
  __syncthreads();
#pragma unroll
  for (int mi = 0; mi < 4; ++mi)
#pragma unroll
    for (int r = 0; r < 4; ++r) {
      const int tk = mi * 16 + lq * 4 + r;
      const float rstd = rsqrtf((red[tk] + red[64 + tk] + red[128 + tk] + red[192 + tk]) * (1.f / 128.f) + EPS);
#pragma unroll
      for (int j = 0; j < 2; ++j) {
        const int col = (2 * wid + j) * 16 + lr;
        const size_t idx = (size_t)(t0 + tk) * 512 + h * 128 + col;
        OC[idx] = f2bf(O[mi][j][r] * rstd * p.onw[l * 128 + col] * siluf_(bf2f(RZ[idx])));
      }
    }
}

constexpr int ATT_BUF = 31744;
template <int DK, bool FIXED>
DI void attn_pass(f32x16 (&O)[4], const bf16_t* __restrict__ Qw  , int ldq, const bf16_t* __restrict__ Kp, int ldk,
                  const bf16_t* __restrict__ Vt, int ntb, int ntw, unsigned char* ldsb, float M2) {
  static_assert(FIXED, "only the fixed-shift softmax is implemented");
  constexpr int KS = DK / 16, KST = DK + 8, CPR = DK / 8, NKC = 64 * CPR / 256;
  const int tid = otid(), lane = tid & 63, l31 = lane & 31, hf = lane >> 5;
  bf16x8 qf[KS];
#pragma unroll
  for (int ks = 0; ks < KS; ++ks) qf[ks] = *(const bf16x8*)(Qw + (size_t)l31 * ldq + ks * 16 + hf * 8);
#pragma unroll
  for (int d = 0; d < 4; ++d)
#pragma unroll
    for (int r = 0; r < 16; ++r) O[d][r] = 0.f;
  float ps0 = 0.f, ps1 = 0.f, ps2 = 0.f, ps3 = 0.f;
  bf16x8 rk[NKC], rv[4];
#define ATT_LOADK(rk_, k0_) { _Pragma("unroll") for (int i = 0; i < NKC; ++i) { int c = tid + 256 * i, row = c / CPR, kc = (c % CPR) * 8; rk_[i] = *(const bf16x8*)(Kp + (size_t)((k0_) + row) * ldk + kc); } }
#define ATT_LOADV(rv_, k0_) { _Pragma("unroll") for (int i = 0; i < 4; ++i) { int c = tid + 256 * i, row = c >> 3, tc = (c & 7) * 8; rv_[i] = *(const bf16x8*)(Vt + (size_t)row * TT + (k0_) + tc); } }
#define ATT_STOREK(rk_, buf_) { bf16_t* sK_ = (bf16_t*)(ldsb + (buf_) * ATT_BUF); _Pragma("unroll") for (int i = 0; i < NKC; ++i) { int c = tid + 256 * i, row = c / CPR, kc = (c % CPR) * 8; *(bf16x8*)(sK_ + row * KST + kc) = rk_[i]; } }
#define ATT_STOREV(rv_, buf_) { bf16_t* sV_ = (bf16_t*)(ldsb + (buf_) * ATT_BUF + 13312); _Pragma("unroll") for (int i = 0; i < 4; ++i) { int c = tid + 256 * i, row = c >> 3, tc = (c & 7) * 8; *(bf16x8*)(sV_ + row * 72 + tc) = rv_[i]; } }
#define ATT_QK(sX, buf_)                                                                                                 \
  {                                                                                                                      \
    const bf16_t* sK = (const bf16_t*)(ldsb + (buf_) * ATT_BUF);                                                         \
    _Pragma("unroll") for (int r = 0; r < 16; ++r) { sX[0][r] = -M2; sX[1][r] = -M2; }                                   \
    _Pragma("unroll") for (int ks = 0; ks < KS; ++ks) {                                                                  \
      bf16x8 k0_ = *(const bf16x8*)(sK + l31 * KST + ks * 16 + hf * 8), k1_ = *(const bf16x8*)(sK + (32 + l31) * KST + ks * 16 + hf * 8); \
      sX[0] = mfma32(k0_, qf[ks], sX[0]); sX[1] = mfma32(k1_, qf[ks], sX[1]);                                            \
    }                                                                                                                    \
  }
#define ATT_EXPG(pfX, g_)                                                                                                \
  {                                                                                                                      \
    const int kb_ = (g_) >> 1, r0_ = ((g_) & 1) * 8;                                                                     \
    float e0 = __builtin_amdgcn_exp2f(sS[kb_][r0_]), e1 = __builtin_amdgcn_exp2f(sS[kb_][r0_ + 1]), e2 = __builtin_amdgcn_exp2f(sS[kb_][r0_ + 2]), e3 = __builtin_amdgcn_exp2f(sS[kb_][r0_ + 3]); \
    float e4 = __builtin_amdgcn_exp2f(sS[kb_][r0_ + 4]), e5 = __builtin_amdgcn_exp2f(sS[kb_][r0_ + 5]), e6 = __builtin_amdgcn_exp2f(sS[kb_][r0_ + 6]), e7 = __builtin_amdgcn_exp2f(sS[kb_][r0_ + 7]); \
    ps0 += e0 + e4; ps1 += e1 + e5; ps2 += e2 + e6; ps3 += e3 + e7;                                                      \
    pfX[g_] = pack8(e0, e1, e2, e3, e4, e5, e6, e7);                                                                     \
  }
#define ATT_STEP(t_, pc, pn, par_)                                                                                       \
  {                                                                                                                      \
    if ((t_) + 2 < ntb) ATT_STOREK(rk, par_)                                                                             \
    if ((t_) + 1 < ntb) ATT_STOREV(rv, (par_) ^ 1)                                                                       \
    if ((t_) + 3 < ntb) ATT_LOADK(rk, ((t_) + 3) * 64)                                                                   \
    if ((t_) + 2 < ntb) ATT_LOADV(rv, ((t_) + 2) * 64)                                                                   \
    if ((t_) < ntw) {                                                                                                    \
      const bf16_t* sV = (const bf16_t*)(ldsb + (par_) * ATT_BUF + 13312);                                               \
      bf16x8 vf[4];                                                                                                      \
      if ((t_) + 1 < ntw) {                                                                                              \
        f32x16 sS[2];                                                                                                    \
        ATT_QK(sS, (par_) ^ 1)                                                                                           \
        _Pragma("unroll") for (int g = 0; g < 4; ++g) {                                                                  \
          _Pragma("unroll") for (int d = 0; d < 4; ++d) vf[d] = *(const bf16x8*)(sV + (d * 32 + l31) * 72 + g * 16 + hf * 8); \
          _Pragma("unroll") for (int d = 0; d < 4; ++d) O[d] = mfma32(vf[d], pc[g], O[d]);                               \
          ATT_EXPG(pn, g)                                                                                                \
          __builtin_amdgcn_sched_barrier(0);                                                                             \
        }                                                                                                                \
      } else {                                                                                                           \
        _Pragma("unroll") for (int g = 0; g < 4; ++g) {                                                                  \
          _Pragma("unroll") for (int d = 0; d < 4; ++d) vf[d] = *(const bf16x8*)(sV + (d * 32 + l31) * 72 + g * 16 + hf * 8); \
          _Pragma("unroll") for (int d = 0; d < 4; ++d) O[d] = mfma32(vf[d], pc[g], O[d]);                               \
          __builtin_amdgcn_sched_barrier(0);                                                                             \
        }                                                                                                                \
      }                                                                                                                  \
    }                                                                                                                    \
    __syncthreads();                                                                                                     \
  }
  bf16x8 pfA[4], pfB[4];
  {
    bf16x8 rkb[NKC];
    ATT_LOADK(rk, 0) ATT_LOADK(rkb, 64) ATT_LOADV(rv, 0)
    ATT_STOREK(rk, 0) ATT_STOREK(rkb, 1) ATT_STOREV(rv, 0)
  }
  if (ntb > 2) ATT_LOADK(rk, 128)
  ATT_LOADV(rv, 64)
  __syncthreads();
  {
    f32x16 sS[2];
    ATT_QK(sS, 0)
    ATT_EXPG(pfA, 0) ATT_EXPG(pfA, 1) ATT_EXPG(pfA, 2) ATT_EXPG(pfA, 3)
  }
  __syncthreads();
  for (int t = 0; t < ntb; t += 2) {
    ATT_STEP(t, pfA, pfB, 0)
    ATT_STEP(t + 1, pfB, pfA, 1)
  }
#undef ATT_EXPG
#undef ATT_LOADK
#undef ATT_LOADV
#undef ATT_STOREK
#undef ATT_STOREV
#undef ATT_QK
#undef ATT_STEP
  float lsum = (ps0 + ps1) + (ps2 + ps3);
  lsum += __shfl_xor(lsum, 32);
  const float inv = 1.f / lsum;
#pragma unroll
  for (int d = 0; d < 4; ++d)
#pragma unroll
    for (int r = 0; r < 16; ++r) O[d][r] *= inv;
}
DI void attn_store(const f32x16 (&O)[4], bf16_t* dst  , int ld) {
  const int lane = otid() & 63, l31 = lane & 31, hf = lane >> 5;
#pragma unroll
  for (int d = 0; d < 4; ++d)
#pragma unroll
    for (int g = 0; g < 4; ++g) {
      const int dv = d * 32 + g * 8 + hf * 4;
      f32x4 v = {O[d][4 * g], O[d][4 * g + 1], O[d][4 * g + 2], O[d][4 * g + 3]};
      st_bf4(dst + (size_t)l31 * ld + dv, v);
    }
}
DI void diffmap_item(const Params& p, int l, int h, int map, int qt, unsigned char* lds) {
  const int wid = otid() >> 6;
  const bf16_t* RA = (const bf16_t*)(p.ws + OFF_RA);
  const bf16_t* VT = (const bf16_t*)(p.ws + OFF_VTA) + (size_t)h * 128 * TT;
  bf16_t* DO = (bf16_t*)(p.ws + (map == 0 ? OFF_O1 : OFF_RB));
  const int row0 = qt * 128 + wid * 32, ntb = 2 * qt + 2, ntw = 2 * qt + 1 + (wid >> 1);
  f32x16 O[4];
  const int lane = otid() & 63;
  float wq = fabsf(p.dqn[l * 64 + lane]), wk = fabsf(p.dkn[l * 64 + lane]);
#pragma unroll
  for (int o = 32; o >= 1; o >>= 1) { wq = fmaxf(wq, __shfl_xor(wq, o)); wk = fmaxf(wk, __shfl_xor(wk, o)); }
  const float M2 = 8.f * LOG2E * 1.03f * wq * wk;
  const bf16_t* Qp_ = RA + (size_t)row0 * 1536 + h * 128 + map * 64; const bf16_t* Kp_ = RA + 512 + h * 128 + map * 64;
  attn_pass<64, true>(O, Qp_, 1536, Kp_, 1536, VT, ntb, ntw, lds, fminf(M2, 60.f));
  attn_store(O, DO + (size_t)row0 * 512 + h * 128, 512);
}
DI void mla_item(const Params& p, int l, int h, int qt, unsigned char* lds) {
  const int wid = otid() >> 6;
  const bf16_t* QB = (const bf16_t*)(p.ws + OFF_QB); const bf16_t* KB = (const bf16_t*)(p.ws + OFF_KB);
  const bf16_t* VT = (const bf16_t*)(p.ws + OFF_VTB) + (size_t)h * 128 * TT;
  bf16_t* OB = (bf16_t*)(p.ws + OFF_CQ);
  const int row0 = qt * 128 + wid * 32, ntb = 2 * qt + 2, ntw = 2 * qt + 1 + (wid >> 1);
  f32x16 O[4];
  const int lane = otid() & 63;
  float wq = fmaxf(fabsf(p.mqn[l * 96 + lane]), lane < 32 ? fabsf(p.mqn[l * 96 + 64 + lane]) : 0.f);
  float wk = fmaxf(fabsf(p.mkn[l * 96 + lane]), lane < 32 ? fabsf(p.mkn[l * 96 + 64 + lane]) : 0.f);
#pragma unroll
  for (int o = 32; o >= 1; o >>= 1) { wq = fmaxf(wq, __shfl_xor(wq, o)); wk = fmaxf(wk, __shfl_xor(wk, o)); }
  const float M2 = 9.797959f * LOG2E * 1.03f * wq * wk;
  attn_pass<96, true>(O, QB + (size_t)row0 * 384 + h * 96, 384, KB + h * 96, 384, VT, ntb, ntw, lds, fminf(M2, 60.f));
  attn_store(O, OB + (size_t)row0 * 512 + h * 128, 512);
}
DI void diffpost_item(const Params& p, int l, int item) {
  const int lane = otid() & 63, wid = otid() >> 6;
  const float lambda_init = 0.8f - 0.6f * expf(-0.3f * (float)l);
  float lam;
  { const float* lp = p.dlam + l * 256; float s01 = wave_sum(lp[lane] * lp[64 + lane]), s23 = wave_sum(lp[128 + lane] * lp[192 + lane]); lam = expf(s01) - expf(s23) + lambda_init; }
  const bf16_t* D1 = (const bf16_t*)(p.ws + OFF_O1); const bf16_t* D2 = (const bf16_t*)(p.ws + OFF_RB);
  bf16_t* RA = (bf16_t*)(p.ws + OFF_RA);
  const float* sw = p.dsub + l * 128 + (lane & 15) * 8;
  f32x4 w0 = *(const f32x4*)sw, w1 = *(const f32x4*)(sw + 4);
#pragma unroll 4
  for (int rr = 0; rr < 16; ++rr) {
    const int t = item * 64 + wid * 16 + rr;
    u32x4 a = *(const u32x4*)(D1 + (size_t)t * 512 + lane * 8), b = *(const u32x4*)(D2 + (size_t)t * 512 + lane * 8);
    unsigned aw[4] = {a.x, a.y, a.z, a.w}, bw[4] = {b.x, b.y, b.z, b.w};
    float o[8]; float ss = 0.f;
#pragma unroll
    for (int j = 0; j < 4; ++j) { o[2 * j] = bflo(aw[j]) - lam * bflo(bw[j]); o[2 * j + 1] = bfhi(aw[j]) - lam * bfhi(bw[j]); ss += o[2 * j] * o[2 * j] + o[2 * j + 1] * o[2 * j + 1]; }
    ss += __shfl_xor(ss, 1); ss += __shfl_xor(ss, 2); ss += __shfl_xor(ss, 4); ss += __shfl_xor(ss, 8);
    const float rs = rsqrtf(ss * (1.f / 128.f) + EPS) * (1.f - lambda_init);
    u32x4 ov; ov.x = pk2(o[0] * rs * w0[0], o[1] * rs * w0[1]); ov.y = pk2(o[2] * rs * w0[2], o[3] * rs * w0[3]);
    ov.z = pk2(o[4] * rs * w1[0], o[5] * rs * w1[1]); ov.w = pk2(o[6] * rs * w1[2], o[7] * rs * w1[3]);
    *(u32x4*)(RA + (size_t)t * 1536 + lane * 8) = ov;
  }
}

DI void gdnpost_item(const Params& p, int l, int item, float* so) {
  const int tid = otid(); const int tt = item >> 2, h = item & 3, t0 = tt * 64;
  const bf16_t* OST = (const bf16_t*)(p.ws + OFF_CQ + 16 * MiB);
  const bf16_t* RZ = (const bf16_t*)(p.ws + OFF_RZ);
  bf16_t* OC = (bf16_t*)(p.ws + OFF_CQ + 32 * MiB);
  float* part = so + 128 * 65; float* rstd = part + 256;
  __syncthreads();
  for (int e = 0; e < 32; ++e) { int idx = tid + 256 * e, d = idx >> 6, tk = idx & 63; so[d * 65 + tk] = bf2f(OST[(size_t)(h * 128 + d) * TT + t0 + tk]); }
  __syncthreads();
  { int tk = tid & 63, pq = tid >> 6; float s = 0.f; for (int d = pq * 32; d < pq * 32 + 32; ++d) { float v = so[d * 65 + tk]; s += v * v; } part[pq * 64 + tk] = s; }
  __syncthreads();
  if (tid < 64) rstd[tid] = rsqrtf((part[tid] + part[64 + tid] + part[128 + tid] + part[192 + tid]) * (1.f / 128.f) + EPS);
  __syncthreads();
  for (int e = 0; e < 32; ++e) {
    int idx = tid + 256 * e, tk = idx >> 7, d = idx & 127;
    float z = bf2f(RZ[(size_t)(t0 + tk) * 512 + h * 128 + d]);
    OC[(size_t)(t0 + tk) * 512 + h * 128 + d] = f2bf(so[d * 65 + tk] * rstd[tk] * p.onw[l * 128 + d] * siluf_(z));
  }
}

#define XB_TMO      128
#define XB_XCNT(j)  (256  + 64 * (j))
#define XB_XSUB(j)  (1280 + 64 * (j))
#define XB_XGEN(j)  (2304 + 64 * (j))
#define XB_TOP      3328
#define XB_TOPGEN   3392
#define XCD_BAR_WORDS 3456
#define XB_SPIN_CAP (1u << 18)
#define LAS __attribute__((address_space(3)))
DI unsigned xb_ld(unsigned* p) { return __hip_atomic_load(p, __ATOMIC_RELAXED, __HIP_MEMORY_SCOPE_AGENT); }
DI unsigned xb_add(unsigned* p, unsigned v) { return __hip_atomic_fetch_add(p, v, __ATOMIC_RELAXED, __HIP_MEMORY_SCOPE_AGENT); }
DI unsigned xb_xcc_id() { return (unsigned)__builtin_amdgcn_s_getreg((3 << 11) | 20) & 0xFu; }
#define XB_SPIN(cond, bar) do { unsigned _sp = 0; while (cond) { __builtin_amdgcn_s_sleep(1); \
    if ((++_sp & 255u) == 0u) { if (xb_ld(&(bar)[XB_TMO])) break; if (_sp > XB_SPIN_CAP) { atomicAdd(&(bar)[XB_TMO], 1u); break; } } } } while (0)
struct XcdBarrier { unsigned* bar; unsigned x; volatile LAS unsigned* st; };
DI XcdBarrier xcd_barrier_post(unsigned* bar, volatile LAS unsigned* st) {
  XcdBarrier b; b.bar = bar; b.x = xb_xcc_id(); b.st = st;
  if (threadIdx.x == 0) (void)xb_add(&bar[XB_XCNT(b.x)], 1u);
  return b;
}
DI void xcd_barrier_complete(unsigned* bar, unsigned x, unsigned& nloc, unsigned& nx) {
  const unsigned G = gridDim.x * gridDim.y * gridDim.z;
  unsigned sum, cnt, mine, sp = 0u;
  for (;;) {
    sum = 0u; cnt = 0u; mine = 0u;
#pragma unroll
    for (unsigned j = 0; j < 16; ++j) { const unsigned c = xb_ld(&bar[XB_XCNT(j)]); sum += c; cnt += (c > 0u) ? 1u : 0u; mine = (j == x) ? c : mine; }
    if (sum == G) break;
    __builtin_amdgcn_s_sleep(1);
    if ((++sp & 255u) == 0u) { if (xb_ld(&bar[XB_TMO])) break; if (sp > XB_SPIN_CAP) { atomicAdd(&bar[XB_TMO], 1u); break; } }
  }
  nloc = mine > 0u ? mine : 1u; nx = cnt > 0u ? cnt : 1u;
}
DI void xcd_barrier(const XcdBarrier& b) {
  asm volatile("s_waitcnt vmcnt(0)" ::: "memory");
  __syncthreads();
  if (threadIdx.x == 0) {
    unsigned* bar = b.bar;
    __builtin_amdgcn_s_waitcnt(0);
    unsigned nloc = b.st[0], nx = b.st[1];
    if (nloc == 0u) { xcd_barrier_complete(bar, b.x, nloc, nx); b.st[0] = nloc; b.st[1] = nx; }
    const unsigned old = xb_add(&bar[XB_XSUB(b.x)], 1u);
    const unsigned gen = old / nloc;
    if (old + 1u == (gen + 1u) * nloc) {
      __builtin_amdgcn_fence(__ATOMIC_RELEASE, "agent");
      asm volatile("s_waitcnt vmcnt(0)" ::: "memory");
      const unsigned og = xb_add(&bar[XB_TOP], 1u);
      const unsigned tg = og / nx;
      if (og + 1u == (tg + 1u) * nx) xb_add(&bar[XB_TOPGEN], 1u);
      else XB_SPIN(xb_ld(&bar[XB_TOPGEN]) == tg, bar);
      __builtin_amdgcn_fence(__ATOMIC_ACQUIRE, "agent");
      xb_add(&bar[XB_XGEN(b.x)], 1u);
      asm volatile("s_waitcnt vmcnt(0)" ::: "memory");
    } else {
      XB_SPIN(xb_ld(&bar[XB_XGEN(b.x)]) == gen, bar);
      __builtin_amdgcn_fence(__ATOMIC_ACQUIRE, "agent");
      asm volatile("s_waitcnt vmcnt(0)" ::: "memory");
    }
  }
  __syncthreads();
}

#define XCD_GEMM_STATIC(NT, CALL)                                                                   \
  {                                                                                                 \
    if ((G & 7) == 0) {                                                                             \
      const int x_ = B & 7, lb_ = B >> 3, NL_ = G >> 3;                                             \
      for (int j_ = lb_; j_ < 16 * (NT); j_ += NL_) {                                               \
        const int sr_ = j_ / (8 * (NT)), rem_ = j_ % (8 * (NT));                                    \
        const int it = (16 * x_ + 8 * sr_ + (rem_ & 7)) * (NT) + (rem_ >> 3);                       \
        CALL;                                                                                       \
      }                                                                                             \
    } else {                                                                                        \
      for (int it = B; it < 128 * (NT); it += G) { CALL; }                                          \
    }                                                                                               \
  }

constexpr int NPH = 1 + 4 * 11;
DI void run_phase(const Params& pin, int ph, unsigned char* lds, int* s_item) {
  Params p = pin;
  {
    size_t z_ = 0; asm volatile("" : "+s"(z_)); p.ws = pin.ws + z_;
  }
  const int tid = otid(); const int G = gridDim.x, B = blockIdx.x;
  if (ph == 0) {
    const int nW = 2 * WT_PER_LAYER;
    for (int it = B; it < nW + 192; it += G) { if (it < nW) w_tile(p, it, (float*)lds); else mod_item(p, it - nW, (float*)lds); }
    return;
  }
  const int ps = (ph - 1) / 11, k = (ph - 1) % 11, b = ps >> 1, l = ps & 1;
  const float* mod = (const float*)(p.ws + OFF_MOD) + (l * 2 + b) * 6144;
  const float* xin = (l == 0 ? p.x : p.out) + (size_t)b * TT * 1024;
  float* xo = p.out + (size_t)b * TT * 1024;
  const unsigned char* WL = p.ws + OFF_W + (size_t)l * W_LAYER;
  switch (k) {
    case 0: for (int it = B; it < 1024; it += G) norm_item(xin, p.norm1_w + l * 1024, mod, mod + 1024, (bf16_t*)(p.ws + OFF_HB), it); break;
    case 1: XCD_GEMM_STATIC(29, inproj_item(p, l, it, (bf16_t*)lds)) break;
    case 2: for (int it = B; it < 1152 + 1024; it += G) { if (it < 1152) upproj_item(p, l, it, (bf16_t*)lds); else prep_ew_item(p, l, it - 1152, (bf16_t*)lds); } break;
    case 3: for (int it = B; it < 1024 + 1024; it += G) { if (it < 1024) gdnprep_item(p, it, lds); else bpost_item(p, l, b, it - 1024, (bf16_t*)lds); } break;
    case 4: {
      unsigned* ctr = (unsigned*)(p.ws + OFF_CTR) + ps * 8;
      const int myx = (int)(xb_xcc_id() & 7u);
      for (int dx = 0; dx < 8; ++dx) {
        const int x = (myx + dx) & 7;
        for (;;) {
          if (tid == 0) *s_item = (int)atomicAdd(ctr + x, 1u);
          __syncthreads();
          const int j = *s_item;
          __syncthreads();
          if (j >= 193) break;
          if (j == 0) scan_item(p, x, lds);
          else {
            const int g = (j - 1) / 3, k = (j - 1) % 3;
            if (k < 2) diffmap_item(p, l, x >> 1, x & 1, 127 - 2 * g - k, lds);
            else mla_item(p, l, x >> 1, 127 - 2 * g - (x & 1), lds);
          }
        }
      }
    } break;
    case 5: for (int it = B; it < 1024 + 256; it += G) { if (it < 1024) gdnout_item(p, l, it, (float*)lds); else diffpost_item(p, l, it - 1024); } break;
    case 6: XCD_GEMM_STATIC(8, merge_item(p, l, it, (bf16_t*)lds)) break;
    case 7: XCD_GEMM_STATIC(4, resid_gemm_item((const bf16_t*)(p.ws + OFF_HB), 1024, (const bf16_t*)(WL + W_OUT), 1024, xin, xo, mod + 2048, it, (bf16_t*)lds)) break;
    case 8: for (int it = B; it < 1024; it += G) norm_item(xo, p.norm2_w + l * 1024, mod + 3072, mod + 4096, (bf16_t*)(p.ws + OFF_HB), it); break;
    case 9: XCD_GEMM_STATIC(22, ffn1_item(p, l, it, (bf16_t*)lds)) break;
    case 10: XCD_GEMM_STATIC(4, resid_gemm_item((const bf16_t*)(p.ws + OFF_RG), FH, (const bf16_t*)(WL + W_DOWN), FH, xo, xo, mod + 5120, it, (bf16_t*)lds)) break;
  }
}

__global__ void __launch_bounds__(256, 2) mega(Params p, int ph_lo, int ph_hi) {
  __shared__ __attribute__((aligned(16))) unsigned char lds[63488];
  __shared__ int s_item;
  __shared__ uint4 xb_words;
  if (threadIdx.x == 0) xb_words = make_uint4(0u, 0u, 0u, 0u);
  __syncthreads();
  XcdBarrier xb = xcd_barrier_post((unsigned*)p.ws, (volatile LAS unsigned*)&xb_words);
  for (int ph = ph_lo; ph < ph_hi; ++ph) {
    if (ph > ph_lo) xcd_barrier(xb);
    if (ph_hi < 0) cg::this_grid().sync();
    run_phase(p, ph, lds, &s_item);
  }
}

extern "C" void kernel_launch(void* const* d_in, const int* in_sizes, int n_in, void* d_out, int out_size, void* d_ws, size_t ws_size, hipStream_t stream) {
  Params p{};
  p.x = (const float*)d_in[0]; p.c = (const float*)d_in[1]; p.pos = (const int*)d_in[2];
  p.ada_w = (const float*)d_in[3]; p.ada_b = (const float*)d_in[4]; p.norm1_w = (const float*)d_in[5]; p.w_in = (const float*)d_in[6];
  p.dqn = (const float*)d_in[7]; p.dkn = (const float*)d_in[8]; p.dlam = (const float*)d_in[9]; p.dsub = (const float*)d_in[10]; p.wod = (const float*)d_in[11];
  p.qa_nw = (const float*)d_in[12]; p.q_up = (const float*)d_in[13]; p.kva_nw = (const float*)d_in[14]; p.kv_up = (const float*)d_in[15];
  p.mqn = (const float*)d_in[16]; p.mkn = (const float*)d_in[17]; p.wom = (const float*)d_in[18]; p.convw = (const float*)d_in[19];
  p.alog = (const float*)d_in[20]; p.dtb = (const float*)d_in[21]; p.onw = (const float*)d_in[22]; p.wog = (const float*)d_in[23];
  p.wout = (const float*)d_in[24]; p.norm2_w = (const float*)d_in[25]; p.wgu = (const float*)d_in[26]; p.wdown = (const float*)d_in[27];
  p.out = (float*)d_out; p.ws = (unsigned char*)d_ws;
  if (ws_size < WS_NEED) { fprintf(stderr, "workspace too small: %zu < %zu\n", ws_size, (size_t)WS_NEED); }
  static int grid_blocks = 0;
  if (!grid_blocks) {
    int dev = 0, cus = 0, per_cu = 0;
    hipGetDevice(&dev);
    hipDeviceGetAttribute(&cus, hipDeviceAttributeMultiprocessorCount, dev);
    hipOccupancyMaxActiveBlocksPerMultiprocessor(&per_cu, mega, 256, 0);
    if (per_cu > 2) per_cu = 2;
    if (per_cu < 1) per_cu = 1;
    grid_blocks = cus * per_cu;
  }
  hipMemsetAsync(d_ws, 0, 16384, stream);
#if ONE_LAUNCH
  int lo = 0, hi = NPH;
  void* args[] = {&p, &lo, &hi};
  hipError_t e = hipLaunchCooperativeKernel((void*)mega, dim3(grid_blocks), dim3(256), args, 0, stream);
  if (e != hipSuccess) fprintf(stderr, "cooperative launch failed: %s (grid %d)\n", hipGetErrorString(e), grid_blocks);
#else
  for (int ph = 0; ph < NPH; ++ph) mega<<<dim3(grid_blocks), dim3(256), 0, stream>>>(p, ph, ph + 1);
#endif
}
```

```cpp
#include <hip/hip_runtime.h>
#include <hip/hip_cooperative_groups.h>
#include <cstdio>
#include <cstdint>
namespace cg = cooperative_groups;

#ifndef ONE_LAUNCH
#define ONE_LAUNCH 1
#endif

typedef unsigned short bf16_t;
typedef short bf16x8 __attribute__((ext_vector_type(8)));
typedef float f32x4 __attribute__((ext_vector_type(4)));
typedef float f32x16 __attribute__((ext_vector_type(16)));
typedef unsigned u32x4 __attribute__((ext_vector_type(4)));
typedef unsigned u32x2 __attribute__((ext_vector_type(2)));
#define DI __device__ __forceinline__

constexpr int TT = 16384;
constexpr int NIN = 7424;
constexpr int FH = 2816;
constexpr float EPS = 1e-6f;
constexpr float LOG2E = 1.4426950408889634f;

struct Params {
  const float *x, *c; const int* pos;
  const float *ada_w, *ada_b, *norm1_w, *w_in, *dqn, *dkn, *dlam, *dsub, *wod, *qa_nw, *q_up, *kva_nw, *kv_up,
      *mqn, *mkn, *wom, *convw, *alog, *dtb, *onw, *wog, *wout, *norm2_w, *wgu, *wdown;
  float* out; unsigned char* ws;
};

constexpr size_t MiB = 1ull << 20;
constexpr size_t OFF_CTR = 0, OFF_MOD = 65536, OFF_W = 1 * MiB;
constexpr size_t W_IN = 0;
constexpr size_t W_OA = W_IN + (size_t)NIN * 1024 * 2;
constexpr size_t W_OB = W_OA + 1024 * 512 * 2;
constexpr size_t W_OC = W_OB + 1024 * 512 * 2;
constexpr size_t W_QUP = W_OC + 1024 * 512 * 2;
constexpr size_t W_KVUP = W_QUP + 384 * 384 * 2;
constexpr size_t W_OUT = W_KVUP + 768 * 256 * 2;
constexpr size_t W_GU = W_OUT + 1024 * 1024 * 2;
constexpr size_t W_DOWN = W_GU + (size_t)5632 * 1024 * 2;
constexpr size_t W_LAYER = W_DOWN + (size_t)1024 * 2816 * 2;
static_assert(OFF_W + 2 * W_LAYER <= 76 * MiB, "weights");
constexpr size_t OFF_HB = 76 * MiB;
constexpr size_t OFF_RA = 108 * MiB;
constexpr size_t OFF_RB = 156 * MiB;
constexpr size_t OFF_RC = 180 * MiB;
constexpr size_t OFF_RZ = 228 * MiB;
constexpr size_t OFF_RG = 244 * MiB;
constexpr size_t OFF_BA = 340 * MiB;
constexpr size_t OFF_YQ = 341 * MiB;
constexpr size_t OFF_CQ = 353 * MiB;
constexpr size_t OFF_VTA = 401 * MiB;
constexpr size_t OFF_QB = 417 * MiB;
constexpr size_t OFF_KB = 429 * MiB;
constexpr size_t OFF_VTB = 441 * MiB;
constexpr size_t OFF_UT = 457 * MiB;
constexpr size_t OFF_ATT = 473 * MiB;
constexpr size_t OFF_GC = 481 * MiB;
constexpr size_t OFF_O1 = 482 * MiB;
constexpr size_t WS_NEED = 498 * MiB;

DI int otid() { int t = (int)__builtin_amdgcn_workitem_id_x(); asm volatile("" : "+v"(t)); return t; }
DI float bf2f(unsigned h) { return __uint_as_float(h << 16); }
typedef __bf16 bf16x2_t __attribute__((ext_vector_type(2)));
typedef float f32x2_t __attribute__((ext_vector_type(2)));
DI unsigned pk2(float lo, float hi) { f32x2_t v; v[0] = lo; v[1] = hi; bf16x2_t b = __builtin_convertvector(v, bf16x2_t); return __builtin_bit_cast(unsigned, b); }
DI bf16_t f2bf(float f) { return (bf16_t)(pk2(f, 0.f) & 0xffffu); }
DI float bflo(unsigned u) { return __uint_as_float(u << 16); }
DI float bfhi(unsigned u) { return __uint_as_float(u & 0xffff0000u); }
DI f32x4 mfma16(bf16x8 a, bf16x8 b, f32x4 c) { return __builtin_amdgcn_mfma_f32_16x16x32_bf16(a, b, c, 0, 0, 0); }
DI f32x16 mfma32(bf16x8 a, bf16x8 b, f32x16 c) { return __builtin_amdgcn_mfma_f32_32x32x16_bf16(a, b, c, 0, 0, 0); }
DI bf16x8 pack8(float a0, float a1, float a2, float a3, float a4, float a5, float a6, float a7) {
  u32x4 u; u.x = pk2(a0, a1); u.y = pk2(a2, a3); u.z = pk2(a4, a5); u.w = pk2(a6, a7);
  return __builtin_bit_cast(bf16x8, u);
}
DI float sigmoidf_(float x) { return 1.f / (1.f + __expf(-x)); }
DI float siluf_(float x) { return x / (1.f + __expf(-x)); }
DI int perm32(int x) { return ((x >> 2) & 3) * 8 + (x >> 4) * 4 + (x & 3); }
DI float wave_sum(float v) {
#pragma unroll
  for (int o = 32; o >= 1; o >>= 1) v += __shfl_xor(v, o);
  return v;
}

DI int win_map(int n) {
  if (n < 1536) return n;
  if (n < 3072) return 2208 + (n - 1536);
  if (n < 3584) return 3744 + (n - 3072);
  if (n < 6656) return 4264 + (n - 3584);
  if (n < 7040) return 1536 + (n - 6656);
  if (n < 7328) return 1920 + (n - 7040);
  if (n < 7336) return 4256 + (n - 7328);
  return -1;
}
DI int gu_map(int n) { int hb = n >> 5, r = n & 31; return r < 16 ? hb * 16 + r : 2816 + hb * 16 + (r - 16); }

constexpr int WT_PER_LAYER = 4692;
DI void w_tile(const Params& p, int item, float* tl) {
  const int tid = otid();
  const int l = item / WT_PER_LAYER; int r = item % WT_PER_LAYER;
  const float* src; const float* rs = nullptr; int K, Nsrc, Nd, mapt = 0; size_t doff;
  if (r < 1856) { src = p.w_in + (size_t)l * 1024 * 7336; K = 1024; Nsrc = 7336; Nd = NIN; mapt = 1; doff = W_IN; }
  else if ((r -= 1856) < 128) { src = p.wod + (size_t)l * 512 * 1024; K = 512; Nsrc = 1024; Nd = 1024; doff = W_OA; }
  else if ((r -= 128) < 128) { src = p.wom + (size_t)l * 512 * 1024; K = 512; Nsrc = 1024; Nd = 1024; doff = W_OB; }
  else if ((r -= 128) < 128) { src = p.wog + (size_t)l * 512 * 1024; K = 512; Nsrc = 1024; Nd = 1024; doff = W_OC; }
  else if ((r -= 128) < 36) { src = p.q_up + (size_t)l * 384 * 384; K = 384; Nsrc = 384; Nd = 384; rs = p.qa_nw + l * 384; doff = W_QUP; }
  else if ((r -= 36) < 48) { src = p.kv_up + (size_t)l * 256 * 768; K = 256; Nsrc = 768; Nd = 768; rs = p.kva_nw + l * 256; doff = W_KVUP; }
  else if ((r -= 48) < 256) { src = p.wout + (size_t)l * 1024 * 1024; K = 1024; Nsrc = 1024; Nd = 1024; doff = W_OUT; }
  else if ((r -= 256) < 1408) { src = p.wgu + (size_t)l * 1024 * 5632; K = 1024; Nsrc = 5632; Nd = 5632; mapt = 2; doff = W_GU; }
  else { r -= 1408; src = p.wdown + (size_t)l * 2816 * 1024; K = 2816; Nsrc = 1024; Nd = 1024; doff = W_DOWN; }
  const int nkt = K >> 6; const int n0 = (r / nkt) * 64, k0 = (r % nkt) * 64;
  bf16_t* dst = (bf16_t*)(p.ws + OFF_W + (size_t)l * W_LAYER + doff);
  __syncthreads();
#pragma unroll
  for (int i = 0; i < 4; ++i) {
    const int idx = tid + 256 * i, rr = idx >> 4, c4 = (idx & 15) * 4;
    const int n = n0 + c4; const int sn = mapt == 1 ? win_map(n) : (mapt == 2 ? gu_map(n) : n);
    f32x4 v = {0.f, 0.f, 0.f, 0.f};
    if (sn >= 0) { v = *(const f32x4*)(src + (size_t)(k0 + rr) * Nsrc + sn); if (rs) { const float sc = rs[k0 + rr]; v[0] *= sc; v[1] *= sc; v[2] *= sc; v[3] *= sc; } }
    tl[rr * 65 + c4] = v[0]; tl[rr * 65 + c4 + 1] = v[1]; tl[rr * 65 + c4 + 2] = v[2]; tl[rr * 65 + c4 + 3] = v[3];
  }
  __syncthreads();
#pragma unroll
  for (int i = 0; i < 2; ++i) {
    const int idx = tid + 256 * i, rr = idx & 63, k8 = (idx >> 6) * 8;
    const float* t0 = tl + k8 * 65 + rr;
    *(bf16x8*)(dst + (size_t)(n0 + rr) * K + k0 + k8) = pack8(t0[0], t0[65], t0[130], t0[195], t0[260], t0[325], t0[390], t0[455]);
  }
}
DI void mod_item(const Params& p, int item, float* red) {
  const int tid = otid(); const int l = item / 96, n0 = (item % 96) * 64;
  const int col = n0 + (tid & 63), kq = tid >> 6;
  const float* w = p.ada_w + (size_t)l * 1024 * 6144;
  float a0 = 0.f, a1 = 0.f;
  for (int k = kq * 256; k < kq * 256 + 256; ++k) { float wv = w[(size_t)k * 6144 + col]; a0 += p.c[k] * wv; a1 += p.c[1024 + k] * wv; }
  __syncthreads();
  red[(kq * 64 + (tid & 63)) * 2] = a0; red[(kq * 64 + (tid & 63)) * 2 + 1] = a1;
  __syncthreads();
  if (tid < 128) {
    int cc = tid & 63, b = tid >> 6; float s = 0.f;
    for (int q = 0; q < 4; ++q) s += red[(q * 64 + cc) * 2 + b];
    float* mod = (float*)(p.ws + OFF_MOD);
    mod[(l * 2 + b) * 6144 + n0 + cc] = s + p.ada_b[l * 6144 + n0 + cc];
  }
}

DI void norm_item(const float* xin, const float* nw, const float* sh, const float* sc, bf16_t* hb, int item) {
  const int lane = otid() & 63, wid = otid() >> 6;
  for (int rr = 0; rr < 4; ++rr) {
    const int t = item * 16 + wid * 4 + rr;
    const float* xr = xin + (size_t)t * 1024;
    f32x4 v[4]; float ss = 0.f;
#pragma unroll
    for (int i = 0; i < 4; ++i) { v[i] = *(const f32x4*)(xr + i * 256 + lane * 4); ss += v[i][0] * v[i][0] + v[i][1] * v[i][1] + v[i][2] * v[i][2] + v[i][3] * v[i][3]; }
    ss = wave_sum(ss);
    const float rstd = rsqrtf(ss * (1.f / 1024.f) + EPS);
#pragma unroll
    for (int i = 0; i < 4; ++i) {
      const int c = i * 256 + lane * 4;
      f32x4 w = *(const f32x4*)(nw + c), s1 = *(const f32x4*)(sc + c), s0 = *(const f32x4*)(sh + c);
      float y0 = v[i][0] * rstd * w[0] * (1.f + s1[0]) + s0[0], y1 = v[i][1] * rstd * w[1] * (1.f + s1[1]) + s0[1];
      float y2 = v[i][2] * rstd * w[2] * (1.f + s1[2]) + s0[2], y3 = v[i][3] * rstd * w[3] * (1.f + s1[3]) + s0[3];
      u32x2 o; o.x = pk2(y0, y1); o.y = pk2(y2, y3);
      *(u32x2*)(hb + (size_t)t * 1024 + c) = o;
    }
  }
}

template <int NI>
DI void gemm_kloop(f32x4 (&acc)[4][NI], const bf16_t* __restrict__ A, int lda, const bf16_t* __restrict__ B, int ldb, int K, bf16_t* sA, bf16_t* sB) {
  constexpr int NB = NI / 4 * 4;
  const int tid = otid(), lane = tid & 63, wid = tid >> 6, wr = wid >> 1, wc = wid & 1, lr = lane & 15, lq = lane >> 4;
  bf16x8 ra[4], rb[NB];
  const int nk = K >> 6;
#pragma unroll
  for (int i = 0; i < 4; ++i) { int c = tid + 256 * i, row = c >> 3, kc = (c & 7) * 8; ra[i] = *(const bf16x8*)(A + (size_t)row * lda + kc); }
#pragma unroll
  for (int i = 0; i < NB; ++i) { int c = tid + 256 * i, row = c >> 3, kc = (c & 7) * 8; rb[i] = *(const bf16x8*)(B + (size_t)row * ldb + kc); }
  for (int kt = 0; kt < nk; ++kt) {
    __syncthreads();
#pragma unroll
    for (int i = 0; i < 4; ++i) { int c = tid + 256 * i, row = c >> 3, kc = (c & 7) * 8; *(bf16x8*)(sA + row * 72 + kc) = ra[i]; }
#pragma unroll
    for (int i = 0; i < NB; ++i) { int c = tid + 256 * i, row = c >> 3, kc = (c & 7) * 8; *(bf16x8*)(sB + row * 72 + kc) = rb[i]; }
    __syncthreads();
    if (kt + 1 < nk) {
      const int k0 = (kt + 1) * 64;
#pragma unroll
      for (int i = 0; i < 4; ++i) { int c = tid + 256 * i, row = c >> 3, kc = (c & 7) * 8; ra[i] = *(const bf16x8*)(A + (size_t)row * lda + k0 + kc); }
#pragma unroll
      for (int i = 0; i < NB; ++i) { int c = tid + 256 * i, row = c >> 3, kc = (c & 7) * 8; rb[i] = *(const bf16x8*)(B + (size_t)row * ldb + k0 + kc); }
    }
#pragma unroll
    for (int ks = 0; ks < 2; ++ks) {
      bf16x8 af[4];
#pragma unroll
      for (int mi = 0; mi < 4; ++mi) af[mi] = *(const bf16x8*)(sA + (wr * 64 + mi * 16 + lr) * 72 + ks * 32 + lq * 8);
#pragma unroll
      for (int nh = 0; nh < NI / 4; ++nh) {
        bf16x8 bfr[4];
#pragma unroll
        for (int ni = 0; ni < 4; ++ni) bfr[ni] = *(const bf16x8*)(sB + (wc * (NI * 16) + (nh * 4 + ni) * 16 + lr) * 72 + ks * 32 + lq * 8);
#pragma unroll
        for (int mi = 0; mi < 4; ++mi)
#pragma unroll
          for (int ni = 0; ni < 4; ++ni) acc[mi][nh * 4 + ni] = mfma16(bfr[ni], af[mi], acc[mi][nh * 4 + ni]);
      }
    }
  }
}
template <int NI>
DI void zero_acc(f32x4 (&acc)[4][NI]) {
#pragma unroll
  for (int a = 0; a < 4; ++a)
#pragma unroll
    for (int b = 0; b < NI; ++b) acc[a][b] = (f32x4){0.f, 0.f, 0.f, 0.f};
}
#define EPI_LOOP(body)                                                                                       \
  {                                                                                                          \
    const int lane_ = otid() & 63, wid_ = otid() >> 6;                                             \
    _Pragma("unroll") for (int mi = 0; mi < 4; ++mi) _Pragma("unroll") for (int ni = 0; ni < NI_; ++ni) {    \
      const int t = m0 + (wid_ >> 1) * 64 + mi * 16 + (lane_ & 15);                                          \
      const int cl = (wid_ & 1) * (NI_ * 16) + ni * 16 + (lane_ >> 4) * 4;             \
      f32x4 v = acc[mi][ni];                                                                                 \
      body                                                                                                   \
    }                                                                                                        \
  }
DI void st_bf4(bf16_t* dst, f32x4 v) { u32x2 o; o.x = pk2(v[0], v[1]); o.y = pk2(v[2], v[3]); *(u32x2*)dst = o; }

DI void inproj_item(const Params& p, int l, int item, bf16_t* lds) {
  constexpr int NI_ = 8;
  const int mt = item / 29, nt = item % 29; const int m0 = mt * 128, n0 = nt * 256;
  const bf16_t* A = (const bf16_t*)(p.ws + OFF_HB) + (size_t)m0 * 1024;
  const bf16_t* B = (const bf16_t*)(p.ws + OFF_W + (size_t)l * W_LAYER + W_IN) + (size_t)n0 * 1024;
  f32x4 acc[4][8]; zero_acc<8>(acc);
  gemm_kloop<8>(acc, A, 1024, B, 1024, 1024, lds, lds + 128 * 72);
  bf16_t* dst; int ld, cb;
  if (nt < 6) { dst = (bf16_t*)(p.ws + OFF_RA); ld = 1536; cb = n0; }
  else if (nt < 12) { dst = (bf16_t*)(p.ws + OFF_RC); ld = 1536; cb = n0 - 1536; }
  else if (nt < 14) { dst = (bf16_t*)(p.ws + OFF_RZ); ld = 512; cb = n0 - 3072; }
  else if (nt < 26) { dst = (bf16_t*)(p.ws + OFF_RG); ld = 3072; cb = n0 - 3584; }
  else { dst = (bf16_t*)(p.ws + OFF_RB); ld = 768; cb = n0 - 6656; }
  float* BA = (float*)(p.ws + OFF_BA);
  if (nt < 4) {
    const int lane = otid() & 63, wid = otid() >> 6, lr = lane & 15, lq = lane >> 4;
    const float* nw = (nt < 2 ? p.dqn : p.dkn) + l * 64;
    const float sc = nt < 2 ? 0.125f * LOG2E : 1.f;
#pragma unroll
    for (int mi = 0; mi < 4; ++mi) {
      const int t = m0 + (wid >> 1) * 64 + mi * 16 + lr;
#pragma unroll
      for (int grp = 0; grp < 2; ++grp) {
        float ss = 0.f;
#pragma unroll
        for (int n4 = 0; n4 < 4; ++n4) { f32x4 v = acc[mi][grp * 4 + n4]; ss += v[0] * v[0] + v[1] * v[1] + v[2] * v[2] + v[3] * v[3]; }
        ss += __shfl_xor(ss, 16); ss += __shfl_xor(ss, 32);
        const float rstd = rsqrtf(ss * (1.f / 64.f) + EPS) * sc;
#pragma unroll
        for (int n4 = 0; n4 < 4; ++n4) {
          f32x4 v = acc[mi][grp * 4 + n4]; f32x4 w = *(const f32x4*)(nw + n4 * 16 + lq * 4);
          v[0] *= rstd * w[0]; v[1] *= rstd * w[1]; v[2] *= rstd * w[2]; v[3] *= rstd * w[3];
          st_bf4(dst + (size_t)t * ld + cb + (wid & 1) * 128 + (grp * 4 + n4) * 16 + lq * 4, v);
        }
      }
    }
  } else {
    EPI_LOOP({
      st_bf4(dst + (size_t)t * ld + cb + cl, v);
      if (nt == 28) { int nn = n0 + cl; if (nn >= 7328 && nn < 7336) *(f32x4*)(BA + (size_t)t * 8 + (nn - 7328)) = v; }
    })
  }
}
DI void upproj_item(const Params& p, int l, int item, bf16_t* lds) {
  constexpr int NI_ = 4;
  f32x4 acc[4][4]; zero_acc<4>(acc);
  const bf16_t* RB = (const bf16_t*)(p.ws + OFF_RB);
  if (item < 384) {
    const int mt = item / 3, nt = item % 3, m0 = mt * 128, n0 = nt * 128;
    gemm_kloop<4>(acc, RB + (size_t)m0 * 768, 768, (const bf16_t*)(p.ws + OFF_W + (size_t)l * W_LAYER + W_QUP) + (size_t)n0 * 384, 384, 384, lds, lds + 128 * 72);
    bf16_t* dst = (bf16_t*)(p.ws + OFF_YQ);
    EPI_LOOP({ st_bf4(dst + (size_t)t * 384 + n0 + cl, v); })
  } else {
    item -= 384; const int mt = item / 6, nt = item % 6, m0 = mt * 128, n0 = nt * 128;
    gemm_kloop<4>(acc, RB + (size_t)m0 * 768 + 384, 768, (const bf16_t*)(p.ws + OFF_W + (size_t)l * W_LAYER + W_KVUP) + (size_t)n0 * 256, 256, 256, lds, lds + 128 * 72);
    bf16_t* dst = (bf16_t*)(p.ws + OFF_HB);
    EPI_LOOP({ st_bf4(dst + (size_t)t * 768 + n0 + cl, v); })
  }
}
DI void merge_item(const Params& p, int l, int item, bf16_t* lds) {
  constexpr int NI_ = 4;
  const int mt = item >> 3, nt = item & 7, m0 = mt * 128, n0 = nt * 128;
  u32x2 mg[4][4];
  const bf16_t* RG = (const bf16_t*)(p.ws + OFF_RG);
  bf16_t* dst = (bf16_t*)(p.ws + OFF_HB);
  for (int br = 0; br < 3; ++br) {
    f32x4 acc[4][4]; zero_acc<4>(acc);
    const bf16_t* A; int lda; size_t wo;
    if (br == 0) { A = (const bf16_t*)(p.ws + OFF_RA); lda = 1536; wo = W_OA; }
    else if (br == 1) { A = (const bf16_t*)(p.ws + OFF_CQ); lda = 512; wo = W_OB; }
    else { A = (const bf16_t*)(p.ws + OFF_CQ + 32 * MiB); lda = 512; wo = W_OC; }
    gemm_kloop<4>(acc, A + (size_t)m0 * lda, lda, (const bf16_t*)(p.ws + OFF_W + (size_t)l * W_LAYER + wo) + (size_t)n0 * 512, 512, 512, lds, lds + 128 * 72);
    EPI_LOOP({
      u32x2 g = *(const u32x2*)(RG + (size_t)t * 3072 + br * 1024 + n0 + cl);
      f32x4 o; o[0] = sigmoidf_(bflo(g.x)) * v[0]; o[1] = sigmoidf_(bfhi(g.x)) * v[1]; o[2] = sigmoidf_(bflo(g.y)) * v[2]; o[3] = sigmoidf_(bfhi(g.y)) * v[3];
      if (br > 0) { u32x2 pm = mg[mi][ni]; o[0] += bflo(pm.x); o[1] += bfhi(pm.x); o[2] += bflo(pm.y); o[3] += bfhi(pm.y); }
      u32x2 pk; pk.x = pk2(o[0], o[1]); pk.y = pk2(o[2], o[3]);
      mg[mi][ni] = pk;
      if (br == 2) *(u32x2*)(dst + (size_t)t * 1024 + n0 + cl) = pk;
    })
  }
}
DI void resid_gemm_item(const bf16_t* A, int lda, const bf16_t* W, int K, const float* xin, float* xout, const float* gate, int item, bf16_t* lds) {
  constexpr int NI_ = 8;
  const int mt = item >> 2, nt = item & 3, m0 = mt * 128, n0 = nt * 256;
  f32x4 acc[4][8]; zero_acc<8>(acc);
  gemm_kloop<8>(acc, A + (size_t)m0 * lda, lda, W + (size_t)n0 * K, K, K, lds, lds + 128 * 72);
  EPI_LOOP({
    const int c = n0 + cl;
    f32x4 xo = *(const f32x4*)(xin + (size_t)t * 1024 + c); f32x4 g = *(const f32x4*)(gate + c);
    xo[0] += g[0] * v[0]; xo[1] += g[1] * v[1]; xo[2] += g[2] * v[2]; xo[3] += g[3] * v[3];
    *(f32x4*)(xout + (size_t)t * 1024 + c) = xo;
  })
}
DI void ffn1_item(const Params& p, int l, int item, bf16_t* lds) {
  const int mt = item / 22, nt = item % 22, m0 = mt * 128, n0 = nt * 256;
  f32x4 acc[4][8]; zero_acc<8>(acc);
  gemm_kloop<8>(acc, (const bf16_t*)(p.ws + OFF_HB) + (size_t)m0 * 1024, 1024, (const bf16_t*)(p.ws + OFF_W + (size_t)l * W_LAYER + W_GU) + (size_t)n0 * 1024, 1024, 1024, lds, lds + 128 * 72);
  bf16_t* hid = (bf16_t*)(p.ws + OFF_RG);
  const int lane = otid() & 63, wid = otid() >> 6;
#pragma unroll
  for (int mi = 0; mi < 4; ++mi)
#pragma unroll
    for (int np = 0; np < 4; ++np) {
      const int t = m0 + (wid >> 1) * 64 + mi * 16 + (lane & 15);
      const int hcol = (((n0 + (wid & 1) * 128) >> 5) + np) * 16 + (lane >> 4) * 4;
      f32x4 g = acc[mi][np * 2], u = acc[mi][np * 2 + 1], o;
#pragma unroll
      for (int r = 0; r < 4; ++r) o[r] = siluf_(g[r]) * u[r];
      st_bf4(hid + (size_t)t * FH + hcol, o);
    }
}

DI void vt_transpose(const bf16_t* src, int ld, const float* srs, bf16_t* dstVt, int t0, bf16_t* sT) {
  const int tid = otid();
  __syncthreads();
  {
    const int row = tid >> 4, col8 = (tid & 15) * 8;
    u32x4 v = *(const u32x4*)(src + (size_t)row * ld + col8);
    const float sc = srs ? srs[row] : 1.f;
    unsigned w[4] = {v.x, v.y, v.z, v.w};
#pragma unroll
    for (int j = 0; j < 4; ++j) { sT[row * 130 + col8 + 2 * j] = f2bf(bflo(w[j]) * sc); sT[row * 130 + col8 + 2 * j + 1] = f2bf(bfhi(w[j]) * sc); }
  }
  __syncthreads();
  const int p16 = tid & 15, half = p16 >> 3, jj = p16 & 7, dg = tid >> 4;
  const int key = (jj >> 2) * 8 + half * 4 + (jj & 3);
#pragma unroll
  for (int i = 0; i < 8; ++i) { const int d = dg * 8 + i; dstVt[(size_t)d * TT + t0 + p16] = sT[key * 130 + d]; }
}

DI void prep_ew_item(const Params& p, int l, int item, bf16_t* lds) {
  const int lane = otid() & 63, wid = otid() >> 6;
  const int t0 = item * 16;
  bf16_t* RA = (bf16_t*)(p.ws + OFF_RA);
  const bf16_t* RC = (const bf16_t*)(p.ws + OFF_RC);
  bf16_t* CQ = (bf16_t*)(p.ws + OFF_CQ);
  const float* BA = (const float*)(p.ws + OFF_BA); float* GB = BA ? (float*)(p.ws + OFF_BA + 512 * 1024) : nullptr;
  const int tw = t0 + wid * 4;
#pragma unroll
  for (int part = 0; part < 3; ++part) {
    const int ch = part * 512 + lane * 8;
    f32x4 cw[4][2];
#pragma unroll
    for (int i = 0; i < 4; ++i) { const float* cp = p.convw + ((size_t)l * 4 + i) * 1536 + ch; cw[i][0] = *(const f32x4*)cp; cw[i][1] = *(const f32x4*)(cp + 4); }
    u32x4 xr[7];
#pragma unroll
    for (int j = 0; j < 7; ++j) {
      const int ts = tw - 3 + j;
      xr[j] = (u32x4){0u, 0u, 0u, 0u};
      if (ts >= 0) xr[j] = *(const u32x4*)(RC + (size_t)ts * 1536 + ch);
    }
#pragma unroll
    for (int rr = 0; rr < 4; ++rr) {
      float a[8];
#pragma unroll
      for (int j = 0; j < 8; ++j) a[j] = 0.f;
#pragma unroll
      for (int i = 0; i < 4; ++i) {
        const u32x4 v = xr[rr + i]; const f32x4 c0 = cw[i][0], c1 = cw[i][1];
        a[0] += bflo(v.x) * c0[0]; a[1] += bfhi(v.x) * c0[1]; a[2] += bflo(v.y) * c0[2]; a[3] += bfhi(v.y) * c0[3];
        a[4] += bflo(v.z) * c1[0]; a[5] += bfhi(v.z) * c1[1]; a[6] += bflo(v.w) * c1[2]; a[7] += bfhi(v.w) * c1[3];
      }
      float ss = 0.f;
#pragma unroll
      for (int j = 0; j < 8; ++j) { a[j] = siluf_(a[j]); ss += a[j] * a[j]; }
      float mul = 1.f;
      if (part < 2) {
        ss += __shfl_xor(ss, 1); ss += __shfl_xor(ss, 2); ss += __shfl_xor(ss, 4); ss += __shfl_xor(ss, 8);
        mul = rsqrtf(ss + EPS) * (part == 0 ? 0.08838834764831845f : 1.f);
      }
      u32x4 o; o.x = pk2(a[0] * mul, a[1] * mul); o.y = pk2(a[2] * mul, a[3] * mul); o.z = pk2(a[4] * mul, a[5] * mul); o.w = pk2(a[6] * mul, a[7] * mul);
      *(u32x4*)(CQ + (size_t)(tw + rr) * 1536 + ch) = o;
    }
  }
  if (lane < 32) {
    const int t = tw + (lane >> 3), cidx = lane & 7;
    float r;
    if (cidx < 4) r = sigmoidf_(BA[(size_t)t * 8 + cidx]);
    else { int h = cidx - 4; float xx = BA[(size_t)t * 8 + cidx] + p.dtb[l * 4 + h]; float sp = xx > 20.f ? xx : __logf(1.f + __expf(xx)); r = -__expf(p.alog[l * 4 + h]) * sp; }
    GB[(size_t)t * 8 + cidx] = r;
  }
  for (int h = 0; h < 4; ++h)
    vt_transpose(RA + (size_t)t0 * 1536 + 1024 + h * 128, 1536, nullptr, (bf16_t*)(p.ws + OFF_VTA) + (size_t)h * 128 * TT, t0, lds);
}

DI void bpost_item(const Params& p, int l, int b, int item, bf16_t* lds) {
  const int lane = otid() & 63, wid = otid() >> 6;
  const int t0 = item * 16;
  const bf16_t* RB = (const bf16_t*)(p.ws + OFF_RB);
  const bf16_t* YQ = (const bf16_t*)(p.ws + OFF_YQ);
  const bf16_t* YKV = (const bf16_t*)(p.ws + OFF_HB);
  bf16_t* QB = (bf16_t*)(p.ws + OFF_QB); bf16_t* KB = (bf16_t*)(p.ws + OFF_KB);
  float* srs = (float*)(lds + 64 * 130);
  float invf = 1.000000000e+00f;
  {
    const int fi = lane & 15;
    invf = (fi == 1) ? 5.623413324e-01f : invf;
    invf = (fi == 2) ? 3.162277639e-01f : invf;
    invf = (fi == 3) ? 1.778279394e-01f : invf;
    invf = (fi == 4) ? 1.000000015e-01f : invf;
    invf = (fi == 5) ? 5.623413250e-02f : invf;
    invf = (fi == 6) ? 3.162277490e-02f : invf;
    invf = (fi == 7) ? 1.778279431e-02f : invf;
    invf = (fi == 8) ? 9.999999776e-03f : invf;
    invf = (fi == 9) ? 5.623413250e-03f : invf;
    invf = (fi == 10) ? 3.162277630e-03f : invf;
    invf = (fi == 11) ? 1.778279431e-03f : invf;
    invf = (fi == 12) ? 1.000000047e-03f : invf;
    invf = (fi == 13) ? 5.623413017e-04f : invf;
    invf = (fi == 14) ? 3.162277571e-04f : invf;
    invf = (fi == 15) ? 1.778279402e-04f : invf;
  }
  __syncthreads();
  for (int rr = 0; rr < 4; ++rr) {
    const int t = t0 + wid * 4 + rr;
    float ssq = 0.f, sskv = 0.f;
    {
      const bf16_t* q = RB + (size_t)t * 768;
#pragma unroll
      for (int j = 0; j < 6; ++j) { float v = bf2f(q[lane + 64 * j]); ssq += v * v; }
#pragma unroll
      for (int j = 0; j < 4; ++j) { float v = bf2f(q[384 + lane + 64 * j]); sskv += v * v; }
    }
    ssq = wave_sum(ssq); sskv = wave_sum(sskv);
    const float rq = rsqrtf(ssq * (1.f / 384.f) + EPS), rkv = rsqrtf(sskv * (1.f / 256.f) + EPS);
    if (lane == 0) srs[wid * 4 + rr] = rkv;
    const float ang = (float)p.pos[(size_t)b * TT + t] * invf;
    float sn, cs; sincosf(ang, &sn, &cs);
    const float kr = lane < 32 ? bf2f(RB[(size_t)t * 768 + 640 + lane]) : 0.f;
#pragma unroll
    for (int h = 0; h < 4; ++h) {
#pragma unroll
      for (int qk = 0; qk < 2; ++qk) {
        float e0, e1;
        if (qk == 0) { e0 = bf2f(YQ[(size_t)t * 384 + h * 96 + lane]) * rq; e1 = lane < 32 ? bf2f(YQ[(size_t)t * 384 + h * 96 + 64 + lane]) * rq : 0.f; }
        else { e0 = bf2f(YKV[(size_t)t * 768 + h * 192 + lane]) * rkv; e1 = kr; }
        float ss = wave_sum(e0 * e0 + e1 * e1);
        const float r = rsqrtf(ss * (1.f / 96.f) + EPS);
        const float* nw = (qk == 0 ? p.mqn : p.mkn) + l * 96;
        float n0 = e0 * r * nw[lane];
        float n1 = lane < 32 ? e1 * r * nw[64 + lane] : 0.f;
        float pr = __shfl_xor(n1, 16);
        float ro = (lane < 16) ? (n1 * cs - pr * sn) : (n1 * cs + pr * sn);
        const float sc = qk == 0 ? 0.10206207261596577f * LOG2E : 1.f;
        bf16_t* dst = (qk == 0 ? QB : KB) + (size_t)t * 384 + h * 96;
        dst[lane] = f2bf(n0 * sc);
        if (lane < 32) dst[64 + lane] = f2bf(ro * sc);
      }
    }
  }
  for (int h = 0; h < 4; ++h)
    vt_transpose(YKV + (size_t)t0 * 768 + h * 192 + 64, 768, srs, (bf16_t*)(p.ws + OFF_VTB) + (size_t)h * 128 * TT, t0, lds);
  __syncthreads();
}

DI void gdnprep_item(const Params& p, int item, unsigned char* ldsb) {
  const int tid = otid(), lane = tid & 63, wid = tid >> 6, lr = lane & 15, lq = lane >> 4;
  const int n = item >> 2, h = item & 3, t0 = n * 64;
  bf16_t* sK = (bf16_t*)ldsb; bf16_t* sQ = sK + 64 * 136; float* Lm = (float*)(ldsb + 2 * 64 * 136 * 2);
  float* sgc = Lm + 64 * 64; float* sbeta = sgc + 64;
  const bf16_t* CQ = (const bf16_t*)(p.ws + OFF_CQ);
  const float* GB = (const float*)(p.ws + OFF_BA + 512 * 1024);
  bf16_t* Wp = (bf16_t*)(p.ws + OFF_RC) + (size_t)item * 8192;
  bf16_t* Qp = (bf16_t*)(p.ws + OFF_RC + 16 * MiB) + (size_t)item * 8192;
  bf16_t* KTp = (bf16_t*)(p.ws + OFF_RC + 32 * MiB) + (size_t)item * 8192;
  bf16_t* UTp = (bf16_t*)(p.ws + OFF_UT) + (size_t)item * 8192;
  bf16_t* ATp = (bf16_t*)(p.ws + OFF_ATT) + (size_t)item * 4096;
  float* GCp = (float*)(p.ws + OFF_GC) + (size_t)item * 64;
  __syncthreads();
  if (tid < 64) {
    float g = GB[(size_t)(t0 + tid) * 8 + 4 + h];
#pragma unroll
    for (int o = 1; o < 64; o <<= 1) { float nb = __shfl_up(g, o); if (lane >= o) g += nb; }
    sgc[tid] = g; sbeta[tid] = GB[(size_t)(t0 + tid) * 8 + h]; GCp[tid] = g;
  }
#pragma unroll
  for (int e = 0; e < 4; ++e) {
    int c = tid + 256 * e, row = c >> 4, c8 = (c & 15) * 8;
    *(bf16x8*)(sQ + row * 136 + c8) = *(const bf16x8*)(CQ + (size_t)(t0 + row) * 1536 + h * 128 + c8);
    *(bf16x8*)(sK + row * 136 + c8) = *(const bf16x8*)(CQ + (size_t)(t0 + row) * 1536 + 512 + h * 128 + c8);
  }
  __syncthreads();
  {
    bf16x8 ak[4], aq[4];
#pragma unroll
    for (int s = 0; s < 4; ++s) { ak[s] = *(const bf16x8*)(sK + (wid * 16 + lr) * 136 + s * 32 + lq * 8); aq[s] = *(const bf16x8*)(sQ + (wid * 16 + lr) * 136 + s * 32 + lq * 8); }
#pragma unroll
    for (int nt = 0; nt < 4; ++nt) {
      f32x4 kk = {0.f, 0.f, 0.f, 0.f}, qk = {0.f, 0.f, 0.f, 0.f};
#pragma unroll
      for (int s = 0; s < 4; ++s) { bf16x8 bk = *(const bf16x8*)(sK + (nt * 16 + lr) * 136 + s * 32 + lq * 8); kk = mfma16(ak[s], bk, kk); qk = mfma16(aq[s], bk, qk); }
      const int j = nt * 16 + lr; const float gj = sgc[j];
#pragma unroll
      for (int r = 0; r < 4; ++r) {
        const int i = wid * 16 + lq * 4 + r;
        const float dec = (i >= j) ? __expf(sgc[i] - gj) : 0.f;
        Lm[i * 64 + j] = (i > j) ? sbeta[i] * kk[r] * dec : 0.f;
        ATp[i * 64 + (j & ~31) + perm32(j & 31)] = f2bf(qk[r] * dec);
      }
    }
  }
  __syncthreads();
  {
    const int c = tid & 127; const bool isw = tid >= 128;
    float x[64];
#pragma unroll
    for (int i = 0; i < 64; ++i) {
      if (isw) x[i] = bf2f(sK[i * 136 + c]) * sbeta[i] * __expf(sgc[i]);
      else x[i] = bf2f(CQ[(size_t)(t0 + i) * 1536 + 1024 + h * 128 + c]) * sbeta[i];
    }
#pragma unroll
    for (int i = 1; i < 64; ++i) {
      float a = x[i];
#pragma unroll
      for (int j4 = 0; j4 < (i + 3) / 4; ++j4) {
        f32x4 Lv = *(const f32x4*)(Lm + i * 64 + j4 * 4);
#pragma unroll
        for (int e = 0; e < 4; ++e) if (j4 * 4 + e < i) a -= Lv[e] * x[j4 * 4 + e];
      }
      x[i] = a;
      if ((i & 3) == 3) __builtin_amdgcn_sched_barrier(0);
    }
    if (!isw) {
#pragma unroll
      for (int i8 = 0; i8 < 8; ++i8)
        *(bf16x8*)(UTp + c * 64 + i8 * 8) = pack8(x[i8 * 8], x[i8 * 8 + 1], x[i8 * 8 + 2], x[i8 * 8 + 3], x[i8 * 8 + 4], x[i8 * 8 + 5], x[i8 * 8 + 6], x[i8 * 8 + 7]);
    } else {
      const int pc = (c & ~31) + perm32(c & 31);
#pragma unroll
      for (int i = 0; i < 64; ++i) Wp[i * 128 + pc] = f2bf(-x[i]);
    }
  }
  for (int e = 0; e < 32; ++e) {
    int idx = tid + 256 * e;
    { int i = idx >> 7, d = idx & 127; Qp[i * 128 + (d & ~31) + perm32(d & 31)] = sQ[i * 136 + d]; }
    { int d = idx >> 6, i = idx & 63; KTp[d * 64 + (i & ~31) + perm32(i & 31)] = sK[i * 136 + d]; }
  }
  __syncthreads();
}

DI void scan_item(const Params& p, int sidx, unsigned char* ldsb) {
  const int tid = otid(), lane = tid & 63, wid = tid >> 6, lr = lane & 15, lq = lane >> 4;
  const int h = sidx >> 1, cb = (sidx & 1) * 4 + wid, c0 = cb * 16;
  const bf16_t* Wb = (const bf16_t*)(p.ws + OFF_RC);
  const bf16_t* KTb = (const bf16_t*)(p.ws + OFF_RC + 32 * MiB);
  const bf16_t* UTb = (const bf16_t*)(p.ws + OFF_UT);
  const float* GCb = (const float*)(p.ws + OFF_GC);
  bf16x8* SN = (bf16x8*)(p.ws + OFF_HB);
  bf16x8* VN = (bf16x8*)(p.ws + OFF_CQ + 16 * MiB);
  bf16_t* sW = (bf16_t*)ldsb; bf16_t* sKT = sW + 64 * 136;
  float* sGC = (float*)(ldsb + (64 * 136 + 128 * 72) * 2);
  bf16x8 rgA[8], rgB[8]; u32x2 unA[4], unB[4]; f32x4 gnA, gnB;
#define SCAN_ISSUE(rg, un, gn, nn)                                                                                       \
  {                                                                                                                      \
    const size_t item_ = (size_t)(nn) * 4 + h;                                                                           \
    _Pragma("unroll") for (int i = 0; i < 4; ++i) {                                                                      \
      const int c = tid + 256 * i;                                                                                       \
      rg[i] = *(const bf16x8*)(Wb + item_ * 8192 + (c >> 4) * 128 + (c & 15) * 8);                                       \
      rg[4 + i] = *(const bf16x8*)(KTb + item_ * 8192 + (c >> 3) * 64 + (c & 7) * 8);                                    \
    }                                                                                                                    \
    _Pragma("unroll") for (int mi = 0; mi < 4; ++mi) un[mi] = *(const u32x2*)(UTb + item_ * 8192 + (c0 + lr) * 64 + mi * 16 + lq * 4); \
    gn = *(const f32x4*)(GCb + item_ * 64 + (tid & 15) * 4);                                                             \
  }
#define SCAN_STEP(rg, un, gn, n)                                                                                         \
  {                                                                                                                      \
    __syncthreads();                                                                                                     \
    _Pragma("unroll") for (int i = 0; i < 4; ++i) {                                                                      \
      const int c = tid + 256 * i;                                                                                       \
      *(bf16x8*)(sW + (c >> 4) * 136 + (c & 15) * 8) = rg[i];                                                            \
      *(bf16x8*)(sKT + (c >> 3) * 72 + (c & 7) * 8) = rg[4 + i];                                                         \
    }                                                                                                                    \
    if (tid < 16) *(f32x4*)(sGC + tid * 4) = gn;                                                                         \
    __syncthreads();                                                                                                     \
    f32x4 V[4];                                                                                                          \
    _Pragma("unroll") for (int mi = 0; mi < 4; ++mi) V[mi] = (f32x4){bflo(un[mi].x), bfhi(un[mi].x), bflo(un[mi].y), bfhi(un[mi].y)}; \
    if ((n) + 2 < 256) SCAN_ISSUE(rg, un, gn, (n) + 2)                                                                   \
    f32x4 gcv[4];                                                                                                        \
    _Pragma("unroll") for (int mi = 0; mi < 4; ++mi) gcv[mi] = *(const f32x4*)(sGC + mi * 16 + lq * 4);                  \
    const float gl = sGC[63];                                                                                            \
    const size_t item = (size_t)(n) * 4 + h;                                                                             \
    bf16x8 bs[4];                                                                                                        \
    _Pragma("unroll") for (int s_ = 0; s_ < 4; ++s_) {                                                                   \
      bs[s_] = pack8(S[2 * s_][0], S[2 * s_][1], S[2 * s_][2], S[2 * s_][3], S[2 * s_ + 1][0], S[2 * s_ + 1][1], S[2 * s_ + 1][2], S[2 * s_ + 1][3]); \
      SN[((item * 8 + cb) * 4 + s_) * 64 + lane] = bs[s_];                                                               \
    }                                                                                                                    \
    bf16x8 wf[2][4];     \
    _Pragma("unroll") for (int mi = 0; mi < 4; ++mi) wf[0][mi] = *(const bf16x8*)(sW + (mi * 16 + lr) * 136 + lq * 8);  \
    _Pragma("unroll") for (int s_ = 0; s_ < 4; ++s_) {                                                                   \
      if (s_ < 3) { _Pragma("unroll") for (int mi = 0; mi < 4; ++mi) wf[(s_ + 1) & 1][mi] = *(const bf16x8*)(sW + (mi * 16 + lr) * 136 + (s_ + 1) * 32 + lq * 8); } \
      else { _Pragma("unroll") for (int mi = 0; mi < 4; ++mi) wf[0][mi] = *(const bf16x8*)(sKT + (mi * 16 + lr) * 72 + lq * 8); } \
      __builtin_amdgcn_sched_barrier(0);                                                                                 \
      _Pragma("unroll") for (int mi = 0; mi < 4; ++mi) V[mi] = mfma16(wf[s_ & 1][mi], bs[s_], V[mi]);                    \
      __builtin_amdgcn_sched_barrier(0);                                                                                 \
    }                                                                                                                    \
    bf16x8 bvs[2];                                                                                                       \
    _Pragma("unroll") for (int s2 = 0; s2 < 2; ++s2) {                                                                   \
      f32x4 a = V[2 * s2], b = V[2 * s2 + 1], ga = gcv[2 * s2], gb = gcv[2 * s2 + 1];                                    \
      VN[((item * 8 + cb) * 2 + s2) * 64 + lane] = pack8(a[0], a[1], a[2], a[3], b[0], b[1], b[2], b[3]);                \
      bvs[s2] = pack8(a[0] * __expf(gl - ga[0]), a[1] * __expf(gl - ga[1]), a[2] * __expf(gl - ga[2]), a[3] * __expf(gl - ga[3]), \
                      b[0] * __expf(gl - gb[0]), b[1] * __expf(gl - gb[1]), b[2] * __expf(gl - gb[2]), b[3] * __expf(gl - gb[3])); \
    }                                                                                                                    \
    const float egl = __expf(gl);                                                                                        \
    _Pragma("unroll") for (int mt = 0; mt < 8; ++mt) S[mt] = S[mt] * egl;                                                \
        \
    _Pragma("unroll") for (int q = 0; q < 4; ++q) {                                                                      \
      if (q < 3) { _Pragma("unroll") for (int i = 0; i < 4; ++i) wf[(q + 1) & 1][i] = *(const bf16x8*)(sKT + ((((q + 1) & 1) * 4 + i) * 16 + lr) * 72 + ((q + 1) >> 1) * 32 + lq * 8); } \
      __builtin_amdgcn_sched_barrier(0);                                                                                 \
      _Pragma("unroll") for (int i = 0; i < 4; ++i) S[(q & 1) * 4 + i] = mfma16(wf[q & 1][i], bvs[q >> 1], S[(q & 1) * 4 + i]); \
      __builtin_amdgcn_sched_barrier(0);                                                                                 \
    }                                                                                                                    \
  }
  f32x4 S[8];
#pragma unroll
  for (int i = 0; i < 8; ++i) S[i] = (f32x4){0.f, 0.f, 0.f, 0.f};
  SCAN_ISSUE(rgA, unA, gnA, 0)
  SCAN_ISSUE(rgB, unB, gnB, 1)
  for (int n = 0; n < 256; n += 2) {
    SCAN_STEP(rgA, unA, gnA, n)
    SCAN_STEP(rgB, unB, gnB, n + 1)
  }
#undef SCAN_ISSUE
#undef SCAN_STEP
}
DI void gdnout_item(const Params& p, int l, int item, float* red  ) {
  const int tid = otid(), lane = tid & 63, wid = tid >> 6, lr = lane & 15, lq = lane >> 4;
  const int n = item >> 2, h = item & 3, t0 = n * 64;
  const bf16_t* Qp = (const bf16_t*)(p.ws + OFF_RC + 16 * MiB) + (size_t)item * 8192;
  const bf16_t* ATp = (const bf16_t*)(p.ws + OFF_ATT) + (size_t)item * 4096;
  const float* GCp = (const float*)(p.ws + OFF_GC) + (size_t)item * 64;
  const bf16x8* SN = (const bf16x8*)(p.ws + OFF_HB);
  const bf16x8* VN = (const bf16x8*)(p.ws + OFF_CQ + 16 * MiB);
  const bf16_t* RZ = (const bf16_t*)(p.ws + OFF_RZ);
  bf16_t* OC = (bf16_t*)(p.ws + OFF_CQ + 32 * MiB);
  f32x4 O[4][2];
#pragma unroll
  for (int mi = 0; mi < 4; ++mi) { O[mi][0] = (f32x4){0.f, 0.f, 0.f, 0.f}; O[mi][1] = (f32x4){0.f, 0.f, 0.f, 0.f}; }
#pragma unroll
  for (int s = 0; s < 4; ++s) {
    bf16x8 b0 = SN[(((size_t)item * 8 + 2 * wid) * 4 + s) * 64 + lane], b1 = SN[(((size_t)item * 8 + 2 * wid + 1) * 4 + s) * 64 + lane];
#pragma unroll
    for (int mi = 0; mi < 4; ++mi) {
      bf16x8 aq = *(const bf16x8*)(Qp + (mi * 16 + lr) * 128 + s * 32 + lq * 8);
      O[mi][0] = mfma16(aq, b0, O[mi][0]); O[mi][1] = mfma16(aq, b1, O[mi][1]);
    }
  }
#pragma unroll
  for (int mi = 0; mi < 4; ++mi) {
    f32x4 g = *(const f32x4*)(GCp + mi * 16 + lq * 4);
#pragma unroll
    for (int r = 0; r < 4; ++r) { float e = __expf(g[r]); O[mi][0][r] *= e; O[mi][1][r] *= e; }
  }
#pragma unroll
  for (int s2 = 0; s2 < 2; ++s2) {
    bf16x8 b0 = VN[(((size_t)item * 8 + 2 * wid) * 2 + s2) * 64 + lane], b1 = VN[(((size_t)item * 8 + 2 * wid + 1) * 2 + s2) * 64 + lane];
#pragma unroll
    for (int mi = 0; mi < 4; ++mi) {
      bf16x8 aa = *(const bf16x8*)(ATp + (mi * 16 + lr) * 64 + s2 * 32 + lq * 8);
      O[mi][0] = mfma16(aa, b0, O[mi][0]); O[mi][1] = mfma16(aa, b1, O[mi][1]);
    }
  }
  __syncthreads();
#pragma unroll
  for (int mi = 0; mi < 4; ++mi)
#pragma unroll
    for (int r = 0; r < 4; ++r) {
      float ss = O[mi][0][r] * O[mi][0][r] + O[mi][1][r] * O[mi][1][r];
      ss += __shfl_xor(ss, 1); ss += __shfl_xor(ss, 2); ss += __shfl_xor(ss, 4); ss += __shfl_xor(ss, 8);
      if (lr == 0) red[wid * 64 + mi * 16 + lq * 4 + r] = ss;
    }
  __syncthreads();
#pragma unroll
  for (int mi = 0; mi < 4; ++mi)
#pragma unroll
    for (int r = 0; r < 4; ++r) {
      const int tk = mi * 16 + lq * 4 + r;
      const float rstd = rsqrtf((red[tk] + red[64 + tk] + red[128 + tk] + red[192 + tk]) * (1.f / 128.f) + EPS);
#pragma unroll
      for (int j = 0; j < 2; ++j) {
        const int col = (2 * wid + j) * 16 + lr;
        const size_t idx = (size_t)(t0 + tk) * 512 + h * 128 + col;
        OC[idx] = f2bf(O[mi][j][r] * rstd * p.onw[l * 128 + col] * siluf_(bf2f(RZ[idx])));
      }
    }
}

constexpr int ATT_BUF = 31744;
template <int DK, bool FIXED>
DI void attn_pass(f32x16 (&O)[4], const bf16_t* __restrict__ Qw  , int ldq, const bf16_t* __restrict__ Kp, int ldk,
                  const bf16_t* __restrict__ Vt, int ntb, int ntw, unsigned char* ldsb, float M2) {
  static_assert(FIXED, "only the fixed-shift softmax is implemented");
  constexpr int KS = DK / 16, KST = DK + 8, CPR = DK / 8, NKC = 64 * CPR / 256;
  const int tid = otid(), lane = tid & 63, l31 = lane & 31, hf = lane >> 5;
  bf16x8 qf[KS];
#pragma unroll
  for (int ks = 0; ks < KS; ++ks) qf[ks] = *(const bf16x8*)(Qw + (size_t)l31 * ldq + ks * 16 + hf * 8);
#pragma unroll
  for (int d = 0; d < 4; ++d)
#pragma unroll
    for (int r = 0; r < 16; ++r) O[d][r] = 0.f;
  float ps0 = 0.f, ps1 = 0.f, ps2 = 0.f, ps3 = 0.f;
  bf16x8 rk[NKC], rv[4];
#define ATT_LOADK(rk_, k0_) { _Pragma("unroll") for (int i = 0; i < NKC; ++i) { int c = tid + 256 * i, row = c / CPR, kc = (c % CPR) * 8; rk_[i] = *(const bf16x8*)(Kp + (size_t)((k0_) + row) * ldk + kc); } }
#define ATT_LOADV(rv_, k0_) { _Pragma("unroll") for (int i = 0; i < 4; ++i) { int c = tid + 256 * i, row = c >> 3, tc = (c & 7) * 8; rv_[i] = *(const bf16x8*)(Vt + (size_t)row * TT + (k0_) + tc); } }
#define ATT_STOREK(rk_, buf_) { bf16_t* sK_ = (bf16_t*)(ldsb + (buf_) * ATT_BUF); _Pragma("unroll") for (int i = 0; i < NKC; ++i) { int c = tid + 256 * i, row = c / CPR, kc = (c % CPR) * 8; *(bf16x8*)(sK_ + row * KST + kc) = rk_[i]; } }
#define ATT_STOREV(rv_, buf_) { bf16_t* sV_ = (bf16_t*)(ldsb + (buf_) * ATT_BUF + 13312); _Pragma("unroll") for (int i = 0; i < 4; ++i) { int c = tid + 256 * i, row = c >> 3, tc = (c & 7) * 8; *(bf16x8*)(sV_ + row * 72 + tc) = rv_[i]; } }
#define ATT_QK(sX, buf_)                                                                                                 \
  {                                                                                                                      \
    const bf16_t* sK = (const bf16_t*)(ldsb + (buf_) * ATT_BUF);                                                         \
    _Pragma("unroll") for (int r = 0; r < 16; ++r) { sX[0][r] = -M2; sX[1][r] = -M2; }                                   \
    _Pragma("unroll") for (int ks = 0; ks < KS; ++ks) {                                                                  \
      bf16x8 k0_ = *(const bf16x8*)(sK + l31 * KST + ks * 16 + hf * 8), k1_ = *(const bf16x8*)(sK + (32 + l31) * KST + ks * 16 + hf * 8); \
      sX[0] = mfma32(k0_, qf[ks], sX[0]); sX[1] = mfma32(k1_, qf[ks], sX[1]);                                            \
    }                                                                                                                    \
  }
#define ATT_EXPG(pfX, g_)                                                                                                \
  {                                                                                                                      \
    const int kb_ = (g_) >> 1, r0_ = ((g_) & 1) * 8;                                                                     \
    float e0 = __builtin_amdgcn_exp2f(sS[kb_][r0_]), e1 = __builtin_amdgcn_exp2f(sS[kb_][r0_ + 1]), e2 = __builtin_amdgcn_exp2f(sS[kb_][r0_ + 2]), e3 = __builtin_amdgcn_exp2f(sS[kb_][r0_ + 3]); \
    float e4 = __builtin_amdgcn_exp2f(sS[kb_][r0_ + 4]), e5 = __builtin_amdgcn_exp2f(sS[kb_][r0_ + 5]), e6 = __builtin_amdgcn_exp2f(sS[kb_][r0_ + 6]), e7 = __builtin_amdgcn_exp2f(sS[kb_][r0_ + 7]); \
    ps0 += e0 + e4; ps1 += e1 + e5; ps2 += e2 + e6; ps3 += e3 + e7;                                                      \
    pfX[g_] = pack8(e0, e1, e2, e3, e4, e5, e6, e7);                                                                     \
  }
#define ATT_STEP(t_, pc, pn, par_)                                                                                       \
  {                                                                                                                      \
    if ((t_) + 2 < ntb) ATT_STOREK(rk, par_)                                                                             \
    if ((t_) + 1 < ntb) ATT_STOREV(rv, (par_) ^ 1)                                                                       \
    if ((t_) + 3 < ntb) ATT_LOADK(rk, ((t_) + 3) * 64)                                                                   \
    if ((t_) + 2 < ntb) ATT_LOADV(rv, ((t_) + 2) * 64)                                                                   \
    if ((t_) < ntw) {                                                                                                    \
      const bf16_t* sV = (const bf16_t*)(ldsb + (par_) * ATT_BUF + 13312);                                               \
      bf16x8 vf[4];                                                                                                      \
      if ((t_) + 1 < ntw) {                                                                                              \
        f32x16 sS[2];                                                                                                    \
        ATT_QK(sS, (par_) ^ 1)                                                                                           \
        _Pragma("unroll") for (int g = 0; g < 4; ++g) {                                                                  \
          _Pragma("unroll") for (int d = 0; d < 4; ++d) vf[d] = *(const bf16x8*)(sV + (d * 32 + l31) * 72 + g * 16 + hf * 8); \
          _Pragma("unroll") for (int d = 0; d < 4; ++d) O[d] = mfma32(vf[d], pc[g], O[d]);                               \
          ATT_EXPG(pn, g)                                                                                                \
          __builtin_amdgcn_sched_barrier(0);                                                                             \
        }                                                                                                                \
      } else {                                                                                                           \
        _Pragma("unroll") for (int g = 0; g < 4; ++g) {                                                                  \
          _Pragma("unroll") for (int d = 0; d < 4; ++d) vf[d] = *(const bf16x8*)(sV + (d * 32 + l31) * 72 + g * 16 + hf * 8); \
          _Pragma("unroll") for (int d = 0; d < 4; ++d) O[d] = mfma32(vf[d], pc[g], O[d]);                               \
          __builtin_amdgcn_sched_barrier(0);                                                                             \
        }                                                                                                                \
      }                                                                                                                  \
    }                                                                                                                    \
    __syncthreads();                                                                                                     \
  }
  bf16x8 pfA[4], pfB[4];
  {
    bf16x8 rkb[NKC];
    ATT_LOADK(rk, 0) ATT_LOADK(rkb, 64) ATT_LOADV(rv, 0)
    ATT_STOREK(rk, 0) ATT_STOREK(rkb, 1) ATT_STOREV(rv, 0)
  }
  if (ntb > 2) ATT_LOADK(rk, 128)
  ATT_LOADV(rv, 64)
  __syncthreads();
  {
    f32x16 sS[2];
    ATT_QK(sS, 0)
    ATT_EXPG(pfA, 0) ATT_EXPG(pfA, 1) ATT_EXPG(pfA, 2) ATT_EXPG(pfA, 3)
  }
  __syncthreads();
  for (int t = 0; t < ntb; t += 2) {
    ATT_STEP(t, pfA, pfB, 0)
    ATT_STEP(t + 1, pfB, pfA, 1)
  }
#undef ATT_EXPG
#undef ATT_LOADK
#undef ATT_LOADV
#undef ATT_STOREK
#undef ATT_STOREV
#undef ATT_QK
#undef ATT_STEP
  float lsum = (ps0 + ps1) + (ps2 + ps3);
  lsum += __shfl_xor(lsum, 32);
  const float inv = 1.f / lsum;
#pragma unroll
  for (int d = 0; d < 4; ++d)
#pragma unroll
    for (int r = 0; r < 16; ++r) O[d][r] *= inv;
}
DI void attn_store(const f32x16 (&O)[4], bf16_t* dst  , int ld) {
  const int lane = otid() & 63, l31 = lane & 31, hf = lane >> 5;
#pragma unroll
  for (int d = 0; d < 4; ++d)
#pragma unroll
    for (int g = 0; g < 4; ++g) {
      const int dv = d * 32 + g * 8 + hf * 4;
      f32x4 v = {O[d][4 * g], O[d][4 * g + 1], O[d][4 * g + 2], O[d][4 * g + 3]};
      st_bf4(dst + (size_t)l31 * ld + dv, v);
    }
}
DI void diffmap_item(const Params& p, int l, int h, int map, int qt, unsigned char* lds) {
  const int wid = otid() >> 6;
  const bf16_t* RA = (const bf16_t*)(p.ws + OFF_RA);
  const bf16_t* VT = (const bf16_t*)(p.ws + OFF_VTA) + (size_t)h * 128 * TT;
  bf16_t* DO = (bf16_t*)(p.ws + (map == 0 ? OFF_O1 : OFF_RB));
  const int row0 = qt * 128 + wid * 32, ntb = 2 * qt + 2, ntw = 2 * qt + 1 + (wid >> 1);
  f32x16 O[4];
  const int lane = otid() & 63;
  float wq = fabsf(p.dqn[l * 64 + lane]), wk = fabsf(p.dkn[l * 64 + lane]);
#pragma unroll
  for (int o = 32; o >= 1; o >>= 1) { wq = fmaxf(wq, __shfl_xor(wq, o)); wk = fmaxf(wk, __shfl_xor(wk, o)); }
  const float M2 = 8.f * LOG2E * 1.03f * wq * wk;
  const bf16_t* Qp_ = RA + (size_t)row0 * 1536 + h * 128 + map * 64; const bf16_t* Kp_ = RA + 512 + h * 128 + map * 64;
  attn_pass<64, true>(O, Qp_, 1536, Kp_, 1536, VT, ntb, ntw, lds, fminf(M2, 60.f));
  attn_store(O, DO + (size_t)row0 * 512 + h * 128, 512);
}
DI void mla_item(const Params& p, int l, int h, int qt, unsigned char* lds) {
  const int wid = otid() >> 6;
  const bf16_t* QB = (const bf16_t*)(p.ws + OFF_QB); const bf16_t* KB = (const bf16_t*)(p.ws + OFF_KB);
  const bf16_t* VT = (const bf16_t*)(p.ws + OFF_VTB) + (size_t)h * 128 * TT;
  bf16_t* OB = (bf16_t*)(p.ws + OFF_CQ);
  const int row0 = qt * 128 + wid * 32, ntb = 2 * qt + 2, ntw = 2 * qt + 1 + (wid >> 1);
  f32x16 O[4];
  const int lane = otid() & 63;
  float wq = fmaxf(fabsf(p.mqn[l * 96 + lane]), lane < 32 ? fabsf(p.mqn[l * 96 + 64 + lane]) : 0.f);
  float wk = fmaxf(fabsf(p.mkn[l * 96 + lane]), lane < 32 ? fabsf(p.mkn[l * 96 + 64 + lane]) : 0.f);
#pragma unroll
  for (int o = 32; o >= 1; o >>= 1) { wq = fmaxf(wq, __shfl_xor(wq, o)); wk = fmaxf(wk, __shfl_xor(wk, o)); }
  const float M2 = 9.797959f * LOG2E * 1.03f * wq * wk;
  attn_pass<96, true>(O, QB + (size_t)row0 * 384 + h * 96, 384, KB + h * 96, 384, VT, ntb, ntw, lds, fminf(M2, 60.f));
  attn_store(O, OB + (size_t)row0 * 512 + h * 128, 512);
}
DI void diffpost_item(const Params& p, int l, int item) {
  const int lane = otid() & 63, wid = otid() >> 6;
  const float lambda_init = 0.8f - 0.6f * expf(-0.3f * (float)l);
  float lam;
  { const float* lp = p.dlam + l * 256; float s01 = wave_sum(lp[lane] * lp[64 + lane]), s23 = wave_sum(lp[128 + lane] * lp[192 + lane]); lam = expf(s01) - expf(s23) + lambda_init; }
  const bf16_t* D1 = (const bf16_t*)(p.ws + OFF_O1); const bf16_t* D2 = (const bf16_t*)(p.ws + OFF_RB);
  bf16_t* RA = (bf16_t*)(p.ws + OFF_RA);
  const float* sw = p.dsub + l * 128 + (lane & 15) * 8;
  f32x4 w0 = *(const f32x4*)sw, w1 = *(const f32x4*)(sw + 4);
  for (int rr = 0; rr < 16; ++rr) {
    const int t = item * 64 + wid * 16 + rr;
    u32x4 a = *(const u32x4*)(D1 + (size_t)t * 512 + lane * 8), b = *(const u32x4*)(D2 + (size_t)t * 512 + lane * 8);
    unsigned aw[4] = {a.x, a.y, a.z, a.w}, bw[4] = {b.x, b.y, b.z, b.w};
    float o[8]; float ss = 0.f;
#pragma unroll
    for (int j = 0; j < 4; ++j) { o[2 * j] = bflo(aw[j]) - lam * bflo(bw[j]); o[2 * j + 1] = bfhi(aw[j]) - lam * bfhi(bw[j]); ss += o[2 * j] * o[2 * j] + o[2 * j + 1] * o[2 * j + 1]; }
    ss += __shfl_xor(ss, 1); ss += __shfl_xor(ss, 2); ss += __shfl_xor(ss, 4); ss += __shfl_xor(ss, 8);
    const float rs = rsqrtf(ss * (1.f / 128.f) + EPS) * (1.f - lambda_init);
    u32x4 ov; ov.x = pk2(o[0] * rs * w0[0], o[1] * rs * w0[1]); ov.y = pk2(o[2] * rs * w0[2], o[3] * rs * w0[3]);
    ov.z = pk2(o[4] * rs * w1[0], o[5] * rs * w1[1]); ov.w = pk2(o[6] * rs * w1[2], o[7] * rs * w1[3]);
    *(u32x4*)(RA + (size_t)t * 1536 + lane * 8) = ov;
  }
}

DI void gdnpost_item(const Params& p, int l, int item, float* so) {
  const int tid = otid(); const int tt = item >> 2, h = item & 3, t0 = tt * 64;
  const bf16_t* OST = (const bf16_t*)(p.ws + OFF_CQ + 16 * MiB);
  const bf16_t* RZ = (const bf16_t*)(p.ws + OFF_RZ);
  bf16_t* OC = (bf16_t*)(p.ws + OFF_CQ + 32 * MiB);
  float* part = so + 128 * 65; float* rstd = part + 256;
  __syncthreads();
  for (int e = 0; e < 32; ++e) { int idx = tid + 256 * e, d = idx >> 6, tk = idx & 63; so[d * 65 + tk] = bf2f(OST[(size_t)(h * 128 + d) * TT + t0 + tk]); }
  __syncthreads();
  { int tk = tid & 63, pq = tid >> 6; float s = 0.f; for (int d = pq * 32; d < pq * 32 + 32; ++d) { float v = so[d * 65 + tk]; s += v * v; } part[pq * 64 + tk] = s; }
  __syncthreads();
  if (tid < 64) rstd[tid] = rsqrtf((part[tid] + part[64 + tid] + part[128 + tid] + part[192 + tid]) * (1.f / 128.f) + EPS);
  __syncthreads();
  for (int e = 0; e < 32; ++e) {
    int idx = tid + 256 * e, tk = idx >> 7, d = idx & 127;
    float z = bf2f(RZ[(size_t)(t0 + tk) * 512 + h * 128 + d]);
    OC[(size_t)(t0 + tk) * 512 + h * 128 + d] = f2bf(so[d * 65 + tk] * rstd[tk] * p.onw[l * 128 + d] * siluf_(z));
  }
}

#define XB_TMO      128
#define XB_XCNT(j)  (256  + 64 * (j))
#define XB_XSUB(j)  (1280 + 64 * (j))
#define XB_XGEN(j)  (2304 + 64 * (j))
#define XB_TOP      3328
#define XB_TOPGEN   3392
#define XCD_BAR_WORDS 3456
#define XB_SPIN_CAP (1u << 18)
#define LAS __attribute__((address_space(3)))
DI unsigned xb_ld(unsigned* p) { return __hip_atomic_load(p, __ATOMIC_RELAXED, __HIP_MEMORY_SCOPE_AGENT); }
DI unsigned xb_add(unsigned* p, unsigned v) { return __hip_atomic_fetch_add(p, v, __ATOMIC_RELAXED, __HIP_MEMORY_SCOPE_AGENT); }
DI unsigned xb_xcc_id() { return (unsigned)__builtin_amdgcn_s_getreg((3 << 11) | 20) & 0xFu; }
#define XB_SPIN(cond, bar) do { unsigned _sp = 0; while (cond) { __builtin_amdgcn_s_sleep(1); \
    if ((++_sp & 255u) == 0u) { if (xb_ld(&(bar)[XB_TMO])) break; if (_sp > XB_SPIN_CAP) { atomicAdd(&(bar)[XB_TMO], 1u); break; } } } } while (0)
struct XcdBarrier { unsigned* bar; unsigned x; volatile LAS unsigned* st; };
DI XcdBarrier xcd_barrier_post(unsigned* bar, volatile LAS unsigned* st) {
  XcdBarrier b; b.bar = bar; b.x = xb_xcc_id(); b.st = st;
  if (threadIdx.x == 0) (void)xb_add(&bar[XB_XCNT(b.x)], 1u);
  return b;
}
DI void xcd_barrier_complete(unsigned* bar, unsigned x, unsigned& nloc, unsigned& nx) {
  const unsigned G = gridDim.x * gridDim.y * gridDim.z;
  unsigned sum, cnt, mine, sp = 0u;
  for (;;) {
    sum = 0u; cnt = 0u; mine = 0u;
#pragma unroll
    for (unsigned j = 0; j < 16; ++j) { const unsigned c = xb_ld(&bar[XB_XCNT(j)]); sum += c; cnt += (c > 0u) ? 1u : 0u; mine = (j == x) ? c : mine; }
    if (sum == G) break;
    __builtin_amdgcn_s_sleep(1);
    if ((++sp & 255u) == 0u) { if (xb_ld(&bar[XB_TMO])) break; if (sp > XB_SPIN_CAP) { atomicAdd(&bar[XB_TMO], 1u); break; } }
  }
  nloc = mine > 0u ? mine : 1u; nx = cnt > 0u ? cnt : 1u;
}
DI void xcd_barrier(const XcdBarrier& b) {
  asm volatile("s_waitcnt vmcnt(0)" ::: "memory");
  __syncthreads();
  if (threadIdx.x == 0) {
    unsigned* bar = b.bar;
    __builtin_amdgcn_s_waitcnt(0);
    unsigned nloc = b.st[0], nx = b.st[1];
    if (nloc == 0u) { xcd_barrier_complete(bar, b.x, nloc, nx); b.st[0] = nloc; b.st[1] = nx; }
    const unsigned old = xb_add(&bar[XB_XSUB(b.x)], 1u);
    const unsigned gen = old / nloc;
    if (old + 1u == (gen + 1u) * nloc) {
      __builtin_amdgcn_fence(__ATOMIC_RELEASE, "agent");
      asm volatile("s_waitcnt vmcnt(0)" ::: "memory");
      const unsigned og = xb_add(&bar[XB_TOP], 1u);
      const unsigned tg = og / nx;
      if (og + 1u == (tg + 1u) * nx) xb_add(&bar[XB_TOPGEN], 1u);
      else XB_SPIN(xb_ld(&bar[XB_TOPGEN]) == tg, bar);
      __builtin_amdgcn_fence(__ATOMIC_ACQUIRE, "agent");
      xb_add(&bar[XB_XGEN(b.x)], 1u);
      asm volatile("s_waitcnt vmcnt(0)" ::: "memory");
    } else {
      XB_SPIN(xb_ld(&bar[XB_XGEN(b.x)]) == gen, bar);
      __builtin_amdgcn_fence(__ATOMIC_ACQUIRE, "agent");
      asm volatile("s_waitcnt vmcnt(0)" ::: "memory");
    }
  }
  __syncthreads();
}

#define XCD_GEMM_STATIC(NT, CALL)                                                                   \
  {                                                                                                 \
    if ((G & 7) == 0) {                                                                             \
      const int x_ = B & 7, lb_ = B >> 3, NL_ = G >> 3;                                             \
      for (int j_ = lb_; j_ < 16 * (NT); j_ += NL_) {                                               \
        const int sr_ = j_ / (8 * (NT)), rem_ = j_ % (8 * (NT));                                    \
        const int it = (16 * x_ + 8 * sr_ + (rem_ & 7)) * (NT) + (rem_ >> 3);                       \
        CALL;                                                                                       \
      }                                                                                             \
    } else {                                                                                        \
      for (int it = B; it < 128 * (NT); it += G) { CALL; }                                          \
    }                                                                                               \
  }

constexpr int NPH = 1 + 4 * 11;
DI void run_phase(const Params& pin, int ph, unsigned char* lds, int* s_item) {
  Params p = pin;
  {
    size_t z_ = 0; asm volatile("" : "+s"(z_)); p.ws = pin.ws + z_;
  }
  const int tid = otid(); const int G = gridDim.x, B = blockIdx.x;
  if (ph == 0) {
    const int nW = 2 * WT_PER_LAYER;
    for (int it = B; it < nW + 192; it += G) { if (it >= 192) w_tile(p, it - 192, (float*)lds); else mod_item(p, it, (float*)lds); }
    return;
  }
  const int ps = (ph - 1) / 11, k = (ph - 1) % 11, b = ps >> 1, l = ps & 1;
  const float* mod = (const float*)(p.ws + OFF_MOD) + (l * 2 + b) * 6144;
  const float* xin = (l == 0 ? p.x : p.out) + (size_t)b * TT * 1024;
  float* xo = p.out + (size_t)b * TT * 1024;
  const unsigned char* WL = p.ws + OFF_W + (size_t)l * W_LAYER;
  switch (k) {
    case 0: for (int it = B; it < 1024; it += G) norm_item(xin, p.norm1_w + l * 1024, mod, mod + 1024, (bf16_t*)(p.ws + OFF_HB), it); break;
    case 1: XCD_GEMM_STATIC(29, inproj_item(p, l, it, (bf16_t*)lds)) break;
    case 2: for (int it = B; it < 1152 + 1024; it += G) { if (it < 1152) upproj_item(p, l, it, (bf16_t*)lds); else prep_ew_item(p, l, it - 1152, (bf16_t*)lds); } break;
    case 3: for (int it = B; it < 1024 + 1024; it += G) { if (it < 1024) gdnprep_item(p, it, lds); else bpost_item(p, l, b, it - 1024, (bf16_t*)lds); } break;
    case 4: {
      unsigned* ctr = (unsigned*)(p.ws + OFF_CTR) + ps * 8;
      const int myx = (int)(xb_xcc_id() & 7u);
      for (int dx = 0; dx < 8; ++dx) {
        const int x = (myx + dx) & 7;
        for (;;) {
          if (tid == 0) *s_item = (int)atomicAdd(ctr + x, 1u);
          __syncthreads();
          const int j = *s_item;
          __syncthreads();
          if (j >= 193) break;
          if (j == 0) scan_item(p, x, lds);
          else {
            const int g = (j - 1) / 3, k = (j - 1) % 3;
            if (k < 2) diffmap_item(p, l, x >> 1, x & 1, 127 - 2 * g - k, lds);
            else mla_item(p, l, x >> 1, 127 - 2 * g - (x & 1), lds);
          }
        }
      }
    } break;
    case 5: for (int it = B; it < 1024 + 256; it += G) { if (it < 1024) gdnout_item(p, l, it, (float*)lds); else diffpost_item(p, l, it - 1024); } break;
    case 6: XCD_GEMM_STATIC(8, merge_item(p, l, it, (bf16_t*)lds)) break;
    case 7: XCD_GEMM_STATIC(4, resid_gemm_item((const bf16_t*)(p.ws + OFF_HB), 1024, (const bf16_t*)(WL + W_OUT), 1024, xin, xo, mod + 2048, it, (bf16_t*)lds)) break;
    case 8: for (int it = B; it < 1024; it += G) norm_item(xo, p.norm2_w + l * 1024, mod + 3072, mod + 4096, (bf16_t*)(p.ws + OFF_HB), it); break;
    case 9: XCD_GEMM_STATIC(22, ffn1_item(p, l, it, (bf16_t*)lds)) break;
    case 10: XCD_GEMM_STATIC(4, resid_gemm_item((const bf16_t*)(p.ws + OFF_RG), FH, (const bf16_t*)(WL + W_DOWN), FH, xo, xo, mod + 5120, it, (bf16_t*)lds)) break;
  }
}

__global__ void __launch_bounds__(256, 2) mega(Params p, int ph_lo, int ph_hi) {
  __shared__ __attribute__((aligned(16))) unsigned char lds[63488];
  __shared__ int s_item;
  __shared__ uint4 xb_words;
  if (threadIdx.x == 0) xb_words = make_uint4(0u, 0u, 0u, 0u);
  __syncthreads();
  XcdBarrier xb = xcd_barrier_post((unsigned*)p.ws, (volatile LAS unsigned*)&xb_words);
  for (int ph = ph_lo; ph < ph_hi; ++ph) {
    if (ph > ph_lo) xcd_barrier(xb);
    if (ph_hi < 0) cg::this_grid().sync();
    run_phase(p, ph, lds, &s_item);
  }
}

extern "C" void kernel_launch(void* const* d_in, const int* in_sizes, int n_in, void* d_out, int out_size, void* d_ws, size_t ws_size, hipStream_t stream) {
  Params p{};
  p.x = (const float*)d_in[0]; p.c = (const float*)d_in[1]; p.pos = (const int*)d_in[2];
  p.ada_w = (const float*)d_in[3]; p.ada_b = (const float*)d_in[4]; p.norm1_w = (const float*)d_in[5]; p.w_in = (const float*)d_in[6];
  p.dqn = (const float*)d_in[7]; p.dkn = (const float*)d_in[8]; p.dlam = (const float*)d_in[9]; p.dsub = (const float*)d_in[10]; p.wod = (const float*)d_in[11];
  p.qa_nw = (const float*)d_in[12]; p.q_up = (const float*)d_in[13]; p.kva_nw = (const float*)d_in[14]; p.kv_up = (const float*)d_in[15];
  p.mqn = (const float*)d_in[16]; p.mkn = (const float*)d_in[17]; p.wom = (const float*)d_in[18]; p.convw = (const float*)d_in[19];
  p.alog = (const float*)d_in[20]; p.dtb = (const float*)d_in[21]; p.onw = (const float*)d_in[22]; p.wog = (const float*)d_in[23];
  p.wout = (const float*)d_in[24]; p.norm2_w = (const float*)d_in[25]; p.wgu = (const float*)d_in[26]; p.wdown = (const float*)d_in[27];
  p.out = (float*)d_out; p.ws = (unsigned char*)d_ws;
  if (ws_size < WS_NEED) { fprintf(stderr, "workspace too small: %zu < %zu\n", ws_size, (size_t)WS_NEED); }
  static int grid_blocks = 0;
  if (!grid_blocks) {
    int dev = 0, cus = 0, per_cu = 0;
    hipGetDevice(&dev);
    hipDeviceGetAttribute(&cus, hipDeviceAttributeMultiprocessorCount, dev);
    hipOccupancyMaxActiveBlocksPerMultiprocessor(&per_cu, mega, 256, 0);
    if (per_cu > 2) per_cu = 2;
    if (per_cu < 1) per_cu = 1;
    grid_blocks = cus * per_cu;
  }
  hipMemsetAsync(d_ws, 0, 16384, stream);
#if ONE_LAUNCH
  int lo = 0, hi = NPH;
  void* args[] = {&p, &lo, &hi};
  hipError_t e = hipLaunchCooperativeKernel((void*)mega, dim3(grid_blocks), dim3(256), args, 0, stream);
  if (e != hipSuccess) fprintf(stderr, "cooperative launch failed: %s (grid %d)\n", hipGetErrorString(e), grid_blocks);
#else
  for (int ph = 0; ph < NPH; ++ph) mega<<<dim3(grid_blocks), dim3(256), 0, stream>>>(p, ph, ph + 1);
#endif
}
```
